# Optimizing an MI355X kernel written in HIP

```python
import math
import jax, jax.numpy as jnp
from jax import lax
import numpy as np

D_MODEL = 2048
BATCH = 4
SEQ = 4096
DEPTH = 2

HEAD_DIM = 64
DIFF_HEADS = 8
DIFF_QK = 2 * DIFF_HEADS * HEAD_DIM
DIFF_V_DIM = 2 * HEAD_DIM
DIFF_V = DIFF_HEADS * DIFF_V_DIM
Q_BLOCK = 128
SWA_Q_HEADS = 16
SWA_KV_HEADS = 2
SWA_GROUP = SWA_Q_HEADS // SWA_KV_HEADS
SWA_WINDOW = 128
SWA_BLOCK = 128
SWA_Q = SWA_Q_HEADS * HEAD_DIM
SWA_KV = SWA_KV_HEADS * HEAD_DIM
EVEN_SPLITS = [DIFF_QK, DIFF_QK, DIFF_V, SWA_Q, SWA_KV, SWA_KV]
EVEN_IN = sum(EVEN_SPLITS)
MIX_WIDTH = DIFF_V + SWA_Q
LRU_WIDTH = D_MODEL
LRU_BLOCKS = 8
LRU_BLOCK_DIM = LRU_WIDTH // LRU_BLOCKS
CONV_WIDTH = 4
LRU_C = 8.0
D_FF = 4 * D_MODEL
N_EVEN = (DEPTH + 1) // 2
N_ODD = DEPTH // 2
EPS = 1e-6

kernel_name = "hybrid_diffattn_swa_rglru_block"


def rmsnorm(x, g):
    xf = x.astype(jnp.float32)
    y = xf * lax.rsqrt(jnp.mean(xf * xf, axis=-1, keepdims=True) + EPS)
    return (y * g.astype(jnp.float32)).astype(x.dtype)


def diff_attention(q, k, v, lq1, lk1, lq2, lk2, sub_g, lambda_init):
    B, S = q.shape[0], q.shape[1]
    nb = S // Q_BLOCK
    scale = HEAD_DIM ** -0.5
    f32 = jnp.float32
    lam = (jnp.exp(jnp.sum(lq1.astype(f32) * lk1.astype(f32)))
           - jnp.exp(jnp.sum(lq2.astype(f32) * lk2.astype(f32))) + lambda_init)
    qb = q.reshape(B, nb, Q_BLOCK, 2 * DIFF_HEADS, HEAD_DIM).transpose(1, 0, 2, 3, 4)
    kpos = jnp.arange(S)

    def block(args):
        qi, i = args
        s = jnp.einsum('bqhd,bkhd->bhqk', qi, k).astype(f32) * scale
        qpos = i * Q_BLOCK + jnp.arange(Q_BLOCK)
        causal = kpos[None, :] <= qpos[:, None]
        s = jnp.where(causal[None, None], s, -jnp.inf)
        p = jax.nn.softmax(s, axis=-1).reshape(B, DIFF_HEADS, 2, Q_BLOCK, S)
        w = p[:, :, 0] - lam * p[:, :, 1]
        return jnp.einsum('bhqk,bkhe->bqhe', w.astype(v.dtype), v)

    o = lax.map(block, (qb, jnp.arange(nb)))
    o = o.transpose(1, 0, 2, 3, 4).reshape(B, S, DIFF_HEADS, DIFF_V_DIM)
    o = rmsnorm(o, sub_g) * (1.0 - lambda_init)
    return o.reshape(B, S, DIFF_V)


def swa_with_sinks(q, k, v, sinks):
    B, S = q.shape[0], q.shape[1]
    nb = S // SWA_BLOCK
    f32 = jnp.float32
    qb = q.reshape(B, nb, SWA_BLOCK, SWA_KV_HEADS, SWA_GROUP, HEAD_DIM)

    def band(t):
        tb = t.reshape(B, nb, SWA_BLOCK, SWA_KV_HEADS, HEAD_DIM)
        prev = jnp.pad(tb, ((0, 0), (1, 0), (0, 0), (0, 0), (0, 0)))[:, :-1]
        return jnp.concatenate([prev, tb], axis=2)

    kb, vb = band(k), band(v)
    s = jnp.einsum('bnqhgd,bnkhd->bnhgqk', qb, kb).astype(f32) * (HEAD_DIM ** -0.5)
    qpos = jnp.arange(SWA_BLOCK) + SWA_BLOCK
    kpos = jnp.arange(2 * SWA_BLOCK)
    rel = qpos[:, None] - kpos[None, :]
    in_window = (rel >= 0) & (rel < SWA_WINDOW)
    not_pad = (jnp.arange(nb)[:, None] > 0) | (kpos[None, :] >= SWA_BLOCK)
    mask = in_window[None] & not_pad[:, None, :]
    s = jnp.where(mask[None, :, None, None], s, -jnp.inf)
    sink = sinks.astype(f32).reshape(SWA_KV_HEADS, SWA_GROUP)[None, None, :, :, None, None]
    m = jnp.maximum(jnp.max(s, axis=-1, keepdims=True), sink)
    e = jnp.exp(s - m)
    p = e / (jnp.sum(e, axis=-1, keepdims=True) + jnp.exp(sink - m))
    o = jnp.einsum('bnhgqk,bnkhd->bnqhgd', p.astype(v.dtype), vb)
    return o.reshape(B, S, SWA_Q)


def even_mixer(h, w_in, lq1, lk1, lq2, lk2, sub_g, sinks, w_out, lambda_init):
    B, S, _ = h.shape
    proj = h @ w_in
    idx = [int(v) for v in np.cumsum(EVEN_SPLITS)[:-1]]
    qa, ka, va, qs, ks, vs = jnp.split(proj, idx, axis=-1)
    a_out = diff_attention(
        qa.reshape(B, S, 2 * DIFF_HEADS, HEAD_DIM),
        ka.reshape(B, S, 2 * DIFF_HEADS, HEAD_DIM),
        va.reshape(B, S, DIFF_HEADS, DIFF_V_DIM),
        lq1, lk1, lq2, lk2, sub_g, lambda_init)
    b_out = swa_with_sinks(
        qs.reshape(B, S, SWA_Q_HEADS, HEAD_DIM),
        ks.reshape(B, S, SWA_KV_HEADS, HEAD_DIM),
        vs.reshape(B, S, SWA_KV_HEADS, HEAD_DIM),
        sinks)
    return jnp.concatenate([a_out, b_out], axis=-1) @ w_out


def causal_depthwise_conv(x, w, b):
    y = lax.conv_general_dilated(
        x, w[:, None, :], window_strides=(1,), padding=[(CONV_WIDTH - 1, 0)],
        dimension_numbers=('NWC', 'WIO', 'NWC'), feature_group_count=x.shape[-1])
    return y + b


def rglru_mixer(h, w_in, conv_w, conv_b, gate_w, gate_b, lru_lambda, w_out):
    B, S, _ = h.shape
    f32 = jnp.float32
    proj = h @ w_in
    y_branch, x_branch = jnp.split(proj, 2, axis=-1)
    y_branch = jax.nn.gelu(y_branch)
    xc = causal_depthwise_conv(x_branch, conv_w, conv_b)
    xb = xc.reshape(B, S, LRU_BLOCKS, LRU_BLOCK_DIM)
    gates = jnp.einsum('bsnd,gnde->gbsne', xb, gate_w) + gate_b[:, None, None]
    r = jax.nn.sigmoid(gates[0].astype(f32)).reshape(B, S, LRU_WIDTH)
    i = jax.nn.sigmoid(gates[1].astype(f32)).reshape(B, S, LRU_WIDTH)
    log_a = -LRU_C * r * jax.nn.softplus(-lru_lambda.astype(f32))
    a = jnp.exp(log_a)
    u = jnp.sqrt(-jnp.expm1(2.0 * log_a)) * (i * xc.astype(f32))

    def combine(left, right):
        a1, b1 = left
        a2, b2 = right
        return a1 * a2, a2 * b1 + b2

    _, hs = lax.associative_scan(combine, (a, u), axis=1)
    return (hs.astype(h.dtype) * y_branch) @ w_out


def sq_relu_mlp(h, w1, w2):
    z = jax.nn.relu(h @ w1)
    return (z * z) @ w2


def setup_inputs(seed: int = 0) -> dict:
    key = jax.random.key(seed)
    ks = jax.random.split(key, 24)
    f32 = jnp.float32
    nrm = lambda k, shape, s: jax.random.normal(k, shape, f32) * s
    gain = lambda k, shape: 1.0 + 0.05 * jax.random.normal(k, shape, f32)
    a0 = jax.random.uniform(ks[14], (N_ODD, LRU_WIDTH), f32, 0.9, 0.999)
    sig = a0 ** (1.0 / LRU_C)
    return {
        "x": jax.random.normal(ks[0], (BATCH, SEQ, D_MODEL), f32),
        "even_w_in": nrm(ks[1], (N_EVEN, D_MODEL, EVEN_IN), D_MODEL ** -0.5),
        "even_lam_q1": nrm(ks[2], (N_EVEN, HEAD_DIM), 0.1),
        "even_lam_k1": nrm(ks[3], (N_EVEN, HEAD_DIM), 0.1),
        "even_lam_q2": nrm(ks[4], (N_EVEN, HEAD_DIM), 0.1),
        "even_lam_k2": nrm(ks[5], (N_EVEN, HEAD_DIM), 0.1),
        "even_subln_g": gain(ks[6], (N_EVEN, DIFF_V_DIM)),
        "even_sinks": nrm(ks[7], (N_EVEN, SWA_Q_HEADS), 1.0),
        "even_w_out": nrm(ks[8], (N_EVEN, MIX_WIDTH, D_MODEL), MIX_WIDTH ** -0.5),
        "odd_w_in": nrm(ks[9], (N_ODD, D_MODEL, 2 * LRU_WIDTH), D_MODEL ** -0.5),
        "odd_conv_w": nrm(ks[10], (N_ODD, CONV_WIDTH, LRU_WIDTH), CONV_WIDTH ** -0.5),
        "odd_conv_b": nrm(ks[11], (N_ODD, LRU_WIDTH), 0.02),
        "odd_gate_w": nrm(ks[12], (N_ODD, 2, LRU_BLOCKS, LRU_BLOCK_DIM, LRU_BLOCK_DIM), LRU_BLOCK_DIM ** -0.5),
        "odd_gate_b": nrm(ks[13], (N_ODD, 2, LRU_BLOCKS, LRU_BLOCK_DIM), 0.02),
        "odd_lru_lambda": jnp.log(sig) - jnp.log1p(-sig),
        "odd_w_out": nrm(ks[15], (N_ODD, LRU_WIDTH, D_MODEL), LRU_WIDTH ** -0.5),
        "pre_mix_g": gain(ks[16], (DEPTH, D_MODEL)),
        "post_mix_g": gain(ks[17], (DEPTH, D_MODEL)),
        "pre_mlp_g": gain(ks[18], (DEPTH, D_MODEL)),
        "post_mlp_g": gain(ks[19], (DEPTH, D_MODEL)),
        "mlp_w1": nrm(ks[20], (DEPTH, D_MODEL, D_FF), D_MODEL ** -0.5),
        "mlp_w2": nrm(ks[21], (DEPTH, D_FF, D_MODEL), D_FF ** -0.5),
    }


def reference(x, even_w_in, even_lam_q1, even_lam_k1, even_lam_q2, even_lam_k2,
              even_subln_g, even_sinks, even_w_out, odd_w_in, odd_conv_w, odd_conv_b,
              odd_gate_w, odd_gate_b, odd_lru_lambda, odd_w_out, pre_mix_g, post_mix_g,
              pre_mlp_g, post_mlp_g, mlp_w1, mlp_w2):
    for layer in range(DEPTH):
        h = rmsnorm(x, pre_mix_g[layer])
        if layer % 2 == 0:
            e = layer // 2
            lambda_init = 0.8 - 0.6 * math.exp(-0.3 * layer)
            mix = even_mixer(h, even_w_in[e], even_lam_q1[e], even_lam_k1[e],
                             even_lam_q2[e], even_lam_k2[e], even_subln_g[e],
                             even_sinks[e], even_w_out[e], lambda_init)
        else:
            o = layer // 2
            mix = rglru_mixer(h, odd_w_in[o], odd_conv_w[o], odd_conv_b[o],
                              odd_gate_w[o], odd_gate_b[o], odd_lru_lambda[o], odd_w_out[o])
        x = x + rmsnorm(mix, post_mix_g[layer])
        f = sq_relu_mlp(rmsnorm(x, pre_mlp_g[layer]), mlp_w1[layer], mlp_w2[layer])
        x = x + rmsnorm(f, post_mlp_g[layer])
    return x
```

```cpp
#include <hip/hip_runtime.h>
#include <hip/hip_cooperative_groups.h>
#include <cstdio>
#include <cstdint>
namespace cg = cooperative_groups;
namespace pg8 {
#define PG8_LAS __attribute__((address_space(3)))
typedef unsigned short bf16_t;
typedef short bf16x8 __attribute__((ext_vector_type(8)));
typedef float f32x4 __attribute__((ext_vector_type(4)));
typedef unsigned u32x4 __attribute__((ext_vector_type(4)));
constexpr int BM = 256, BK = 64, HALF = 128, HTB = HALF * BK * 2  , STAGE_BYTES = 8 * HTB, NXCD = 8, WGM = 8;

__host__ __device__ __forceinline__ int lds_byte(int r, int c) { const int st = (r >> 4) * 2 + (c >> 5), rr = r & 15, cc = c & 31, ob = rr * 64 + cc * 2; return st * 1024 + (ob ^ (((ob >> 9) & 1) << 5)); }
__host__ __device__ __forceinline__ void stage_rc(int b, int& R, int& C) { const int st = b / 1024, sb = b % 1024, swz = sb ^ (((sb >> 9) & 1) << 5); R = (st >> 1) * 16 + swz / 64; C = (st & 1) * 32 + (swz % 64) / 2; }
__host__ __device__ __forceinline__ int perm32(int rho) { const int n = rho >> 4, i = rho & 15; return 8 * (i >> 2) + 4 * n + (i & 3); }

struct Unit { int pm, pn; };
struct Gemm { const bf16_t* A; const bf16_t* Bt; int M, N, K, lda, ldb, agrp; };

struct StaticOrder {
    int nM, nN, nwg, G, c;
    __host__ __device__ void init(int M, int N, int G_, int c_) { nM = M / BM; nN = N / BM; nwg = nM * nN; G = G_; c = c_; }
    __host__ __device__ bool next(int i, Unit& u) const {
        const long L = (long)i * G + c; if (L >= nwg) return false;
        int wgid = (int)L; { const int q = nwg / NXCD, r = nwg % NXCD, xcd = wgid % NXCD, off = wgid / NXCD; wgid = (xcd < r ? xcd * (q + 1) : r * (q + 1) + (xcd - r) * q) + off; }
        const int nig = WGM * nN, gid = wgid / nig, fm = gid * WGM, gsz = (nM - fm) < WGM ? (nM - fm) : WGM;
        u.pm = fm + ((wgid % nig) % gsz); u.pn = (wgid % nig) / gsz; return true;
    }
    __device__ __forceinline__ void a_ready(const Unit&) const {}
    __device__ __forceinline__ void done(const Unit&) const {}
};

__device__ __forceinline__ unsigned cvt_pk_bf16(float lo, float hi) { unsigned r; asm volatile("v_cvt_pk_bf16_f32 %0, %1, %2" : "=v"(r) : "v"(lo), "v"(hi)); return r; }
__device__ __forceinline__ float act_gelu_tanh(float v) {
    const float u = v * (1.5957691216f + 0.0713548163f * v * v);
    return v * __builtin_amdgcn_rcpf(1.f + __builtin_amdgcn_exp2f(-1.4426950409f * u));
}
constexpr float QSCALE = 0.125f * 1.4426950408889634f;
struct EpiAct {
    static constexpr bool PERM = true, AFTER_DRAIN = false;
    bf16_t* O; int ldc; int mode;
    __device__ __forceinline__ void operator()(const f32x4 (&acc)[2][2][4][2], const Unit& u, int wr, int wc, int fr, int fq) const {
        const int row0 = u.pm * BM + wr * 64 + fr, col0 = u.pn * BM + wc * 32 + 8 * fq;
        int md = mode; float sc = 1.f;
        if (md == 2 && u.pn >= 8) md = 0;
        if (md == 3) { md = 0; if (u.pn < 4 || (u.pn >= 12 && u.pn < 16)) sc = QSCALE; }
#pragma unroll
        for (int ai = 0; ai < 2; ++ai)
#pragma unroll
            for (int m = 0; m < 4; ++m) { bf16_t* rowp = O + (size_t)(row0 + ai * HALF + m * 16) * ldc + col0;
#pragma unroll
                for (int bj = 0; bj < 2; ++bj) { f32x4 v0 = acc[ai][bj][m][0], v1 = acc[ai][bj][m][1];
                    if (md == 1) {
#pragma unroll
                        for (int e = 0; e < 4; ++e) { const float a = fmaxf(v0[e], 0.f), b = fmaxf(v1[e], 0.f); v0[e] = a * a; v1[e] = b * b; }
                    } else if (md == 2) {
#pragma unroll
                        for (int e = 0; e < 4; ++e) { v0[e] = act_gelu_tanh(v0[e]); v1[e] = act_gelu_tanh(v1[e]); }
                    }
                    v0 = v0 * sc; v1 = v1 * sc; u32x4 w; w.x = cvt_pk_bf16(v0[0], v0[1]); w.y = cvt_pk_bf16(v0[2], v0[3]); w.z = cvt_pk_bf16(v1[0], v1[1]); w.w = cvt_pk_bf16(v1[2], v1[3]);
                    *(u32x4*)(rowp + bj * HALF) = w; } }
    }
};
template <class Epi, class Sched, bool ALIGN_EPI = false, bool SP2 = false>
__device__ __forceinline__ void gemm_phase(PG8_LAS unsigned char* lds, const Gemm g, const Sched& S, const Epi& E, const int tid) {
    const int wid = __builtin_amdgcn_readfirstlane(tid >> 6), lane = tid & 63, wr = wid >> 2, wc = wid & 3, fr = lane & 15, fq = lane >> 4;
    const int K = g.K, nt = K / BK;
    unsigned voffA[2], voffB[2];
#pragma unroll
    for (int i = 0; i < 2; ++i) { int R, C; stage_rc(tid * 16 + i * 8192, R, C); const int Rb = Epi::PERM ? ((R & ~31) + perm32(R & 31)) : R;
        voffA[i] = (unsigned)(R * g.lda + C) * 2u; voffB[i] = (unsigned)(Rb * g.ldb + C) * 2u; }
    const size_t kstep = (size_t)(BK * 2);
    const size_t hstepA = (size_t)HALF * g.lda * 2, hstepB = (size_t)HALF * g.ldb * 2;
    const size_t tstepA = 2 * hstepA, tstepB = 2 * hstepB; const size_t agk = g.agrp ? (size_t)K * 2 : 0;
    const unsigned ldsw = (unsigned)wid * 1024u;
    const int aoff = lds_byte(wr * 64 + fr, fq * 8), boff = lds_byte(wc * 32 + fr, fq * 8);
#define PG8_SA(b, h) (((b) * 2 + (h)) * HTB)
#define PG8_SB(b, h) ((4 + (b) * 2 + (h)) * HTB)
#define PG8_STAGE(bufoff, gbase, voff) do { _Pragma("unroll") for (int _i = 0; _i < 2; ++_i) \
        __builtin_amdgcn_global_load_lds((const unsigned*)((const char*)(gbase) + (voff)[_i]), (PG8_LAS unsigned*)(lds + (bufoff) + ldsw + _i * 8192), 16, 0, 0); } while (0)
#define PG8_LDA(dst, b, h) do { _Pragma("unroll") for (int m = 0; m < 4; ++m) _Pragma("unroll") for (int k = 0; k < 2; ++k) dst[m][k] = *(const PG8_LAS bf16x8*)(lds + PG8_SA(b, h) + aoff + m * 2048 + k * 1024); } while (0)
#define PG8_LDB(dst, b, h) do { _Pragma("unroll") for (int n = 0; n < 2; ++n) _Pragma("unroll") for (int k = 0; k < 2; ++k) dst[n][k] = *(const PG8_LAS bf16x8*)(lds + PG8_SB(b, h) + boff + n * 2048 + k * 1024); } while (0)
#define PG8_MMA(ai, bj, At, Bt) do { __builtin_amdgcn_s_setprio(1); _Pragma("unroll") for (int m = 0; m < 4; ++m) _Pragma("unroll") for (int n = 0; n < 2; ++n) _Pragma("unroll") for (int k = 0; k < 2; ++k) \
        acc[ai][bj][m][n] = __builtin_amdgcn_mfma_f32_16x16x32_bf16(Bt[n][k], At[m][k], acc[ai][bj][m][n], 0, 0, 0); __builtin_amdgcn_s_setprio(0); } while (0)
#define PG8_WAIT_V(n) asm volatile("s_waitcnt vmcnt(" #n ")" ::: "memory")
#define PG8_WAIT_L(n) asm volatile("s_waitcnt lgkmcnt(" #n ")" ::: "memory")
#define PG8_BAR __builtin_amdgcn_s_barrier()
#define PG8_SCHED __builtin_amdgcn_sched_barrier(0)
    Unit cur, nxt; int ui = 0;
    if (!S.next(0, cur)) return;
    f32x4 acc[2][2][4][2];
#pragma unroll
    for (int a = 0; a < 2; ++a)
#pragma unroll
        for (int b = 0; b < 2; ++b)
#pragma unroll
            for (int m = 0; m < 4; ++m)
#pragma unroll
                for (int n = 0; n < 2; ++n) acc[a][b][m][n] = (f32x4){0.f, 0.f, 0.f, 0.f};
    bf16x8 At[4][2], B0[2][2], B1[2][2];
    const char* cA = (const char*)g.A + (size_t)cur.pm * tstepA + (size_t)(cur.pn >> 1) * agk; const char* cB = (const char*)g.Bt + (size_t)cur.pn * tstepB;
    S.a_ready(cur);
    if constexpr (SP2) {
        PG8_STAGE(PG8_SB(0, 0), cB, voffB); PG8_STAGE(PG8_SB(0, 1), cB + hstepB, voffB); PG8_STAGE(PG8_SA(0, 0), cA, voffA); PG8_STAGE(PG8_SA(0, 1), cA + hstepA, voffA);
        if (wr == 1) PG8_BAR;
        PG8_WAIT_V(2); PG8_BAR;
        PG8_STAGE(PG8_SB(1, 0), cB + kstep, voffB); PG8_STAGE(PG8_SA(1, 0), cA + kstep, voffA); PG8_STAGE(PG8_SB(1, 1), cB + hstepB + kstep, voffB);
        PG8_WAIT_V(6); PG8_BAR;
    } else {
        PG8_STAGE(PG8_SB(0, 0), cB, voffB); PG8_STAGE(PG8_SA(0, 0), cA, voffA); PG8_STAGE(PG8_SB(0, 1), cB + hstepB, voffB); PG8_STAGE(PG8_SA(0, 1), cA + hstepA, voffA);
        if (wr == 1) PG8_BAR;
        PG8_WAIT_V(4); PG8_BAR;
        PG8_STAGE(PG8_SB(1, 0), cB + kstep, voffB); PG8_STAGE(PG8_SA(1, 0), cA + kstep, voffA); PG8_STAGE(PG8_SB(1, 1), cB + hstepB + kstep, voffB);
        PG8_WAIT_V(6); PG8_BAR;
    }
    for (;;) {
        const bool has_next = S.next(ui + 1, nxt);
        const char* nA = has_next ? (const char*)g.A + (size_t)nxt.pm * tstepA + (size_t)(nxt.pn >> 1) * agk : cA; const char* nB = has_next ? (const char*)g.Bt + (size_t)nxt.pn * tstepB : cB;
        for (int t = 0; t < nt; t += 2) {
            const bool last = (t == nt - 2);
            const char* a1 = cA + (size_t)(t + 1) * kstep;
            const char* a2 = last ? nA : cA + (size_t)(t + 2) * kstep; const char* b2 = last ? nB : cB + (size_t)(t + 2) * kstep;
            const char* a3 = a2 + kstep; const char* b3 = b2 + kstep;
            if (last && has_next) S.a_ready(nxt);
            if constexpr (SP2) {
            PG8_LDB(B0, 0, 0); PG8_LDB(B1, 0, 1); PG8_SCHED; PG8_LDA(At, 0, 0); PG8_STAGE(PG8_SA(1, 1), a1 + hstepA, voffA);
            PG8_WAIT_V(8); PG8_WAIT_L(0); PG8_BAR; PG8_MMA(0, 0, At, B0); PG8_MMA(0, 1, At, B1); PG8_BAR; PG8_SCHED;
            PG8_LDA(At, 0, 1); PG8_STAGE(PG8_SB(0, 0), b2, voffB); PG8_STAGE(PG8_SB(0, 1), b2 + hstepB, voffB); PG8_STAGE(PG8_SA(0, 0), a2, voffA);
            PG8_WAIT_V(8); PG8_WAIT_L(0); PG8_BAR; PG8_MMA(1, 0, At, B0); PG8_MMA(1, 1, At, B1); PG8_BAR; PG8_SCHED;
            PG8_LDB(B0, 1, 0); PG8_LDB(B1, 1, 1); PG8_SCHED; PG8_LDA(At, 1, 0); PG8_STAGE(PG8_SA(0, 1), a2 + hstepA, voffA);
            PG8_WAIT_V(8); PG8_WAIT_L(0); PG8_BAR; PG8_MMA(0, 0, At, B0); PG8_MMA(0, 1, At, B1); PG8_BAR; PG8_SCHED;
            PG8_LDA(At, 1, 1); PG8_STAGE(PG8_SB(1, 0), b3, voffB); PG8_STAGE(PG8_SB(1, 1), b3 + hstepB, voffB); PG8_STAGE(PG8_SA(1, 0), a3, voffA);
            PG8_WAIT_V(8); PG8_WAIT_L(0); PG8_BAR; PG8_MMA(1, 0, At, B0); PG8_MMA(1, 1, At, B1); PG8_BAR; PG8_SCHED;
            } else {
            PG8_LDB(B0, 0, 0); PG8_SCHED; PG8_LDA(At, 0, 0); PG8_STAGE(PG8_SA(1, 1), a1 + hstepA, voffA);
            PG8_WAIT_L(8); PG8_BAR; PG8_WAIT_L(0); PG8_MMA(0, 0, At, B0); PG8_BAR; PG8_SCHED;
            PG8_LDB(B1, 0, 1); PG8_STAGE(PG8_SB(0, 0), b2, voffB);
            PG8_BAR; PG8_WAIT_L(0); PG8_MMA(0, 1, At, B1); PG8_BAR;
            PG8_LDA(At, 0, 1); PG8_STAGE(PG8_SA(0, 0), a2, voffA);
            PG8_BAR; PG8_WAIT_L(0); PG8_MMA(1, 0, At, B0); PG8_BAR; PG8_SCHED;
            PG8_STAGE(PG8_SB(0, 1), b2 + hstepB, voffB);
            PG8_WAIT_V(6); PG8_BAR; PG8_MMA(1, 1, At, B1); PG8_BAR;
            PG8_LDB(B0, 1, 0); PG8_SCHED; PG8_LDA(At, 1, 0); PG8_STAGE(PG8_SA(0, 1), a2 + hstepA, voffA);
            PG8_WAIT_L(8); PG8_BAR; PG8_WAIT_L(0); PG8_MMA(0, 0, At, B0); PG8_BAR; PG8_SCHED;
            PG8_LDB(B1, 1, 1); PG8_STAGE(PG8_SB(1, 0), b3, voffB);
            PG8_BAR; PG8_WAIT_L(0); PG8_MMA(0, 1, At, B1); PG8_BAR;
            PG8_LDA(At, 1, 1); PG8_STAGE(PG8_SA(1, 0), a3, voffA);
            PG8_BAR; PG8_WAIT_L(0); PG8_MMA(1, 0, At, B0); PG8_BAR; PG8_SCHED;
            PG8_STAGE(PG8_SB(1, 1), b3 + hstepB, voffB);
            PG8_WAIT_V(6); PG8_BAR; PG8_MMA(1, 1, At, B1); PG8_BAR;
            }
        }
        if constexpr (ALIGN_EPI) { if (wr == 0) PG8_BAR; }
        if constexpr (!Epi::AFTER_DRAIN) { E(acc, cur, wr, wc, fr, fq); S.done(cur); }
        if (!has_next) break;
#pragma unroll
        for (int a = 0; a < 2; ++a)
#pragma unroll
            for (int b = 0; b < 2; ++b)
#pragma unroll
                for (int m = 0; m < 4; ++m)
#pragma unroll
                    for (int n = 0; n < 2; ++n) acc[a][b][m][n] = (f32x4){0.f, 0.f, 0.f, 0.f};
        cur = nxt; cA = nA; cB = nB; ++ui;
        if constexpr (ALIGN_EPI) { if (wr == 1) PG8_BAR; }
    }
    PG8_WAIT_V(0);
    if constexpr (!ALIGN_EPI) { if (wr == 0) PG8_BAR; }
    PG8_BAR;
    if constexpr (Epi::AFTER_DRAIN) { E.fused(acc, cur, wr, wc, fr, fq, lds, wid, lane); S.done(cur); }
#undef PG8_SA
#undef PG8_SB
#undef PG8_STAGE
#undef PG8_LDA
#undef PG8_LDB
#undef PG8_MMA
#undef PG8_WAIT_V
#undef PG8_WAIT_L
#undef PG8_BAR
#undef PG8_SCHED
}
}
#include <hip/hip_bf16.h>
#include <cmath>
namespace attn_body {
using bf16=__hip_bfloat16;
using bf16x8=__attribute__((ext_vector_type(8)))short;
using s16x4=__attribute__((ext_vector_type(4)))short;
using f32x16=__attribute__((ext_vector_type(16)))float;
using u32x4=__attribute__((ext_vector_type(4)))unsigned;
constexpr int D=64,DM=4352,PO=2048;
constexpr int NW=8,QBLK=32,QB=QBLK*NW,KVBLK=64;
__device__ __forceinline__ int crow(int r,int hi){return (r&3)+8*(r>>2)+4*hi;}
#define SBAR() __builtin_amdgcn_sched_barrier(0)
__device__ __forceinline__ void cmask(f32x16&p0,f32x16&p1,int jb,int qrel,int hi){
  const float NEG=-INFINITY; int kb=64*jb+4*hi;
  #pragma unroll
  for(int r=0;r<16;++r){int kv=kb+(r&3)+8*(r>>2); if(kv>qrel)p0[r]=NEG; if(kv+32>qrel)p1[r]=NEG;}
}

__device__ __forceinline__ void wmask(f32x16&p0,f32x16&p1,int jb,int qrel,int hi){
  const float NEG=-INFINITY; int kb=64*jb+4*hi;
  #pragma unroll
  for(int r=0;r<16;++r){const int dd=qrel-kb-((r&3)+8*(r>>2)); if((unsigned)dd>127u)p0[r]=NEG; if((unsigned)(dd-32)>127u)p1[r]=NEG;}
}
constexpr int NSLOT=3, SLOTB=8192;
constexpr int LDS_K=0, LDS_V=NSLOT*SLOTB, LDS_WS=2*NSLOT*SLOTB, LDS_OST=LDS_WS+NW*64*4, LDS_BYTES=LDS_OST+NW*4096;
constexpr float C2=0.125f*1.4426950408889634f;
__device__ __forceinline__ void glds16(const void*gsrc,unsigned lds_dst){unsigned keep;
  asm volatile("s_mov_b32 %0, m0\n\ts_mov_b32 m0, %2\n\ts_nop 0\n\tglobal_load_lds_dwordx4 %1, off\n\ts_mov_b32 m0, %0":"=&s"(keep):"v"(gsrc),"s"(lds_dst):"memory");}
__device__ __forceinline__ float max3f(float a,float b,float c){float r;asm("v_max3_f32 %0, %1, %2, %3":"=v"(r):"v"(a),"v"(b),"v"(c));return r;}
__device__ __forceinline__ float max2f(float a,float b){float r;asm("v_max_f32_e32 %0, %1, %2":"=v"(r):"v"(a),"v"(b));return r;}
__device__ __forceinline__ float fadd_s(float a,float b){float r;asm("v_add_f32_e32 %0, %1, %2":"=v"(r):"v"(a),"v"(b));return r;}
__device__ __forceinline__ float fsub_s(float a,float b){float r;asm("v_sub_f32_e32 %0, %1, %2":"=v"(r):"v"(a),"v"(b));return r;}
typedef float f32x2_t __attribute__((ext_vector_type(2))); typedef __bf16 bf16x2_t __attribute__((ext_vector_type(2)));
__device__ __forceinline__ unsigned cvtpk_s(float lo,float hi){f32x2_t v={lo,hi};bf16x2_t b=__builtin_convertvector(v,bf16x2_t);return __builtin_bit_cast(unsigned,b);}
#define WAIT_BAR(N) asm volatile("s_waitcnt vmcnt(" #N ") lgkmcnt(0)\n\ts_barrier":::"memory")

__device__ __forceinline__ void qkt(f32x16&p0,f32x16&p1,const char*Kslot,const bf16x8*qr,const f32x16&negm,int r32,int hi){
  const char*kb=Kslot+hi*1024+r32*16;
  #pragma unroll
  for(int d0=0;d0<4;++d0){
    const bf16x8 b0=*reinterpret_cast<const bf16x8*>(kb+d0*2048);
    const bf16x8 b1=*reinterpret_cast<const bf16x8*>(kb+d0*2048+512);
    if(d0==0){p0=__builtin_amdgcn_mfma_f32_32x32x16_bf16(b0,qr[0],negm,0,0,0);p1=__builtin_amdgcn_mfma_f32_32x32x16_bf16(b1,qr[0],negm,0,0,0);}
    else{p0=__builtin_amdgcn_mfma_f32_32x32x16_bf16(b0,qr[d0],p0,0,0,0);p1=__builtin_amdgcn_mfma_f32_32x32x16_bf16(b1,qr[d0],p1,0,0,0);}}
}
typedef __attribute__((address_space(3))) const char* lds_cptr;
typedef short v4i16_t __attribute__((ext_vector_type(4)));
__device__ __forceinline__ void kload8(bf16x8*kf,lds_cptr kp){
  kf[0]=*(const __attribute__((address_space(3))) bf16x8*)(kp);      kf[1]=*(const __attribute__((address_space(3))) bf16x8*)(kp+512);
  kf[2]=*(const __attribute__((address_space(3))) bf16x8*)(kp+2048); kf[3]=*(const __attribute__((address_space(3))) bf16x8*)(kp+2560);
  kf[4]=*(const __attribute__((address_space(3))) bf16x8*)(kp+4096); kf[5]=*(const __attribute__((address_space(3))) bf16x8*)(kp+4608);
  kf[6]=*(const __attribute__((address_space(3))) bf16x8*)(kp+6144); kf[7]=*(const __attribute__((address_space(3))) bf16x8*)(kp+6656);
}
__device__ __forceinline__ void kload2(bf16x8*kf,lds_cptr kp,int j){ kf[2*j]=*(const __attribute__((address_space(3))) bf16x8*)(kp+j*2048); kf[2*j+1]=*(const __attribute__((address_space(3))) bf16x8*)(kp+j*2048+512); }
__device__ __forceinline__ s16x4 vtr(lds_cptr p){ return __builtin_bit_cast(s16x4,__builtin_amdgcn_ds_read_tr16_b64_v4i16((__attribute__((address_space(3))) v4i16_t*)p)); }
__device__ __forceinline__ float rowmax(const f32x16&p0,const f32x16&p1){
  float a=max3f(p0[0],p0[1],p1[0]),b=max3f(p0[2],p0[3],p1[1]);a=max3f(a,p1[2],p1[3]);
  #pragma unroll
  for(int r=4;r<16;r+=4){a=max3f(a,p0[r],p0[r+1]);b=max3f(b,p0[r+2],p0[r+3]);a=max3f(a,p1[r],p1[r+1]);b=max3f(b,p1[r+2],p1[r+3]);}
  const float m=max2f(a,b);
  auto rr=__builtin_amdgcn_permlane32_swap(__float_as_uint(m),__float_as_uint(m),false,false);
  return max2f(__uint_as_float(rr[0]),__uint_as_float(rr[1]));
}
__device__ __forceinline__ void pv(f32x16*o,int vb,bf16x8 pa0,bf16x8 pa1,bf16x8 pa2,bf16x8 pa3){
  #pragma unroll
  for(int d0=0;d0<2;++d0){s16x4 lo[4],hi[4];
    #pragma unroll
    for(int ks=0;ks<4;++ks){
      asm volatile("ds_read_b64_tr_b16 %0,%1 offset:%c2":"=&v"(lo[ks]):"v"(vb),"i"(d0*4096+ks*1024):"memory");
      asm volatile("ds_read_b64_tr_b16 %0,%1 offset:%c2":"=&v"(hi[ks]):"v"(vb),"i"(d0*4096+ks*1024+512):"memory");}
    asm volatile("s_waitcnt lgkmcnt(0)":::"memory");SBAR();
    #define PK(k) (bf16x8){lo[k][0],lo[k][1],lo[k][2],lo[k][3],hi[k][0],hi[k][1],hi[k][2],hi[k][3]}
    o[d0]=__builtin_amdgcn_mfma_f32_32x32x16_bf16(pa0,PK(0),o[d0],0,0,0);
    o[d0]=__builtin_amdgcn_mfma_f32_32x32x16_bf16(pa1,PK(1),o[d0],0,0,0);
    o[d0]=__builtin_amdgcn_mfma_f32_32x32x16_bf16(pa2,PK(2),o[d0],0,0,0);
    o[d0]=__builtin_amdgcn_mfma_f32_32x32x16_bf16(pa3,PK(3),o[d0],0,0,0);
    #undef PK
  }
}

#ifndef ATTN_STORE16
#define ATTN_STORE16(p,v) (*(u32x4*)(p)=(v))
#endif
template<int THRL> __device__ __forceinline__ void attn_unit(const bf16*Qp,const bf16*__restrict__ Kp,const bf16*__restrict__ Vp,bf16*Op,int q0,int t0,const bool SWA,float sink_l2,char*shm,const int tid){
  const int lane=tid&63,r32=lane&31,hi=lane>>5; const int wid=__builtin_amdgcn_readfirstlane(tid>>6);
  const bf16*Qw=Qp+(long)(q0+wid*QBLK)*DM;
  const bf16*Kh=Kp+(long)t0*KVBLK*DM,*Vh=Vp+(long)t0*KVBLK*DM;
  const unsigned lds0=(unsigned)(uintptr_t)shm;
  float*wsf=(float*)(shm+LDS_WS)+wid*64;
  const bf16*ksrc=Kh+(long)lane*DM+wid*8;
  const bf16*vsrc=Vh+(long)(16*(wid&3)+(lane>>2))*DM+(wid>>2)*32+(lane&3)*8;
  const unsigned kdst=lds0+LDS_K+wid*1024, vdst=lds0+LDS_V+wid*1024;
  #define DMA_K(t,slot) glds16(ksrc+(long)(t)*KVBLK*DM,(unsigned)__builtin_amdgcn_readfirstlane(kdst+(slot)))
  #define DMA_V(t,slot) glds16(vsrc+(long)(t)*KVBLK*DM,(unsigned)__builtin_amdgcn_readfirstlane(vdst+(slot)))
  const int vb0=(int)(lds0+LDS_V)+((lane>>4)&1)*32+(lane&3)*8+(4*hi+((lane&15)>>2))*64;
  const char*Kbase=shm+LDS_K; bf16x8 kf[8];
  const lds_cptr shm3=(lds_cptr)shm; const lds_cptr kp0=shm3+LDS_K+hi*1024+r32*16; const lds_cptr vp0=shm3+LDS_V+((lane>>4)&1)*32+(lane&3)*8+(4*hi+((lane&15)>>2))*64;
  const int NT=(q0+QB)/KVBLK-t0;
  DMA_K(0,0);DMA_V(0,0);DMA_K(1,SLOTB);
  bf16x8 qr[4];
  #pragma unroll
  for(int d0=0;d0<4;++d0)qr[d0]=*reinterpret_cast<const bf16x8*>(&Qw[(long)r32*DM+d0*16+hi*8]);
  float mhat=0.f,l_reg=0.f;f32x16 o[2];o[0]=f32x16{};o[1]=f32x16{};f32x16 negm=f32x16{};asm volatile("":"+v"(negm));
  const int qrel=wid*QBLK+r32;
  #define CMASK(P0,P1,t) do{int jb_=(t)-(NT-4); if(SWA)wmask(P0,P1,jb_,qrel,hi); else if(jb_>=0)cmask(P0,P1,jb_,qrel,hi);}while(0)
  bool resc=false;
  #define START(P0,P1) do{ const float rm=rowmax(P0,P1); resc=false; \
    { const float dl=SWA?max2f(rm,sink_l2):rm; mhat=fadd_s(mhat,dl); if(SWA)l_reg=hi?0.f:__builtin_amdgcn_exp2f(sink_l2-dl); \
      _Pragma("unroll") for(int r=0;r<16;++r){P0[r]=fsub_s(P0[r],dl);P1[r]=fsub_s(P1[r],dl);} \
      _Pragma("unroll") for(int r=0;r<16;++r)negm[r]=-mhat; asm volatile("":"+v"(negm)); } \
    _Pragma("unroll") for(int r=0;r<16;++r)P0[r]=__builtin_amdgcn_exp2f(P0[r]); }while(0)
  #define RESC() do{ if(resc){ asm volatile("s_waitcnt lgkmcnt(0)":::"memory"); \
      _Pragma("unroll") for(int d_=0;d_<2;++d_) _Pragma("unroll") for(int r=0;r<16;++r)o[d_][r]*=wsf[crow(r,hi)]; } }while(0)
  f32x16 pA0,pA1,pB0,pB1;
  int sl_prev=0,sl_cur=0,sl_next=SLOTB;
  #define ROT() do{sl_prev=sl_cur;sl_cur=sl_next;sl_next=(sl_next==(NSLOT-1)*SLOTB)?0:sl_next+SLOTB;}while(0)
  DMA_K(2,2*SLOTB);
  WAIT_BAR(3);
  qkt(pA0,pA1,Kbase,qr,negm,r32,hi);asm volatile("s_nop 15\n\ts_nop 7":"+v"(pA0),"+v"(pA1));CMASK(pA0,pA1,0);
  START(pA0,pA1);
  _Pragma("unroll") for(int r=0;r<16;++r)pA1[r]=__builtin_amdgcn_exp2f(pA1[r]);
  WAIT_BAR(0);
  DMA_K(3,0);DMA_V(1,SLOTB);
  ROT();
  kload8(kf,kp0+sl_cur);
  WAIT_BAR(2);
  s16x4 vlo[8],vhi[8]; u32x4 pw0,pw1,pw2,pw3;
  #define PKW(P,B) cvtpk_s(P[B],P[B+1])
  #define PAF(k) __builtin_bit_cast(bf16x8,pw##k)
  #define VFR(i) (bf16x8){vlo[i][0],vlo[i][1],vlo[i][2],vlo[i][3],vhi[i][0],vhi[i][1],vhi[i][2],vhi[i][3]}
  #define PIN(x) asm volatile("":"+v"(x))
  #define MX3(a,b,c) __builtin_fmaxf(__builtin_fmaxf((a),(b)),(c))
  #define GAPA(MF,A0,A1,A2,A3,W0,W1,PW) do{ MF; sacc+=A0; sacc+=A1; sacc+=A2; sacc+=A3; PIN(sacc); W0; W1; PIN(PW); SBAR(); }while(0)
  #define EX(v) __builtin_amdgcn_exp2f(v)
  #define GAPB(MF,X,B) do{ MF; X[B]=EX(X[B]); X[B+1]=EX(X[B+1]); X[B+2]=EX(X[B+2]); X[B+3]=EX(X[B+3]); PIN(X); SBAR(); }while(0)
  #define VRD(i) do{ vlo[i]=vtr(vp_+(((i)>>2)*4096+((i)&3)*1024)); vhi[i]=vtr(vp_+(((i)>>2)*4096+((i)&3)*1024+512)); }while(0)
  #define KRD(G,j) do{ if(G){ kload2(kf,kp0+sl_next,j); SBAR(); } }while(0)
  #define STEP(C0,C1,P0,P1,t,GK,GV,GL) do{ SBAR(); \
    const lds_cptr vp_=vp0+sl_prev; \
    VRD(0); SBAR(); float sacc=(P0[0]+P0[1]); \
    GAPA(C0=__builtin_amdgcn_mfma_f32_32x32x16_bf16(kf[0],qr[0],negm,0,0,0), P0[2],P0[3],P0[4],P0[5],     pw0[0]=PKW(P0,0), pw0[1]=PKW(P0,2), pw0); \
    VRD(4); SBAR(); GAPA(C1=__builtin_amdgcn_mfma_f32_32x32x16_bf16(kf[1],qr[0],negm,0,0,0), P0[6],P0[7],P0[8],P0[9],     pw0[2]=PKW(P0,4), pw0[3]=PKW(P0,6), pw0); \
    VRD(1); SBAR(); GAPA(C0=__builtin_amdgcn_mfma_f32_32x32x16_bf16(kf[2],qr[1],C0,0,0,0),   P0[10],P0[11],P0[12],P0[13], pw1[0]=PKW(P0,8), pw1[1]=PKW(P0,10), pw1); \
    VRD(5); SBAR(); GAPA(C1=__builtin_amdgcn_mfma_f32_32x32x16_bf16(kf[3],qr[1],C1,0,0,0),   P0[14],P0[15],P1[0],P1[1],   pw1[2]=PKW(P0,12),pw1[3]=PKW(P0,14), pw1); \
    VRD(2); SBAR(); GAPA(C0=__builtin_amdgcn_mfma_f32_32x32x16_bf16(kf[4],qr[2],C0,0,0,0),   P1[2],P1[3],P1[4],P1[5],     pw2[0]=PKW(P1,0), pw2[1]=PKW(P1,2), pw2); \
    VRD(6); SBAR(); GAPA(C1=__builtin_amdgcn_mfma_f32_32x32x16_bf16(kf[5],qr[2],C1,0,0,0),   P1[6],P1[7],P1[8],P1[9],     pw2[2]=PKW(P1,4), pw2[3]=PKW(P1,6), pw2); \
    VRD(3); SBAR(); GAPA(C0=__builtin_amdgcn_mfma_f32_32x32x16_bf16(kf[6],qr[3],C0,0,0,0),   P1[10],P1[11],P1[12],P1[13], pw3[0]=PKW(P1,8), pw3[1]=PKW(P1,10), pw3); \
    VRD(7); SBAR(); GAPA(C1=__builtin_amdgcn_mfma_f32_32x32x16_bf16(kf[7],qr[3],C1,0,0,0),   P1[14],P1[15],0.f,0.f,       pw3[2]=PKW(P1,12),pw3[3]=PKW(P1,14), pw3); \
    l_reg+=sacc; \
    if(GK){DMA_K((t)+3,sl_cur);} if(GV){DMA_V((t)+1,sl_next);} \
    CMASK(C0,C1,t); \
    { float a=MX3(C0[0],C0[1],C1[0]),b=MX3(C0[2],C0[3],C1[1]); a=MX3(a,C1[2],C1[3]); \
      _Pragma("unroll") for(int r=4;r<16;r+=4){a=MX3(a,C0[r],C0[r+1]);b=MX3(b,C0[r+2],C0[r+3]);a=MX3(a,C1[r],C1[r+1]);b=MX3(b,C1[r+2],C1[r+3]);} \
      float rm=__builtin_fmaxf(a,b); { auto rr=__builtin_amdgcn_permlane32_swap(__float_as_uint(rm),__float_as_uint(rm),false,false); rm=__builtin_fmaxf(__uint_as_float(rr[0]),__uint_as_float(rr[1])); } \
      resc=false; \
      if(__builtin_expect(__any(rm>(float)THRL),0)){ const float dl=__builtin_fmaxf(rm,0.f); mhat+=dl; \
        _Pragma("unroll") for(int r=0;r<16;++r){C0[r]-=dl;C1[r]-=dl;} \
        _Pragma("unroll") for(int r=0;r<16;++r)negm[r]=-mhat; asm volatile("":"+v"(negm)); \
        const float f=__builtin_amdgcn_exp2f(-dl); l_reg*=f; if(hi==0)wsf[r32]=f; resc=true; } } \
    SBAR(); \
    GAPB(o[0]=__builtin_amdgcn_mfma_f32_32x32x16_bf16(PAF(0),VFR(0),o[0],0,0,0), C0,0); \
    GAPB(o[1]=__builtin_amdgcn_mfma_f32_32x32x16_bf16(PAF(0),VFR(4),o[1],0,0,0), C0,4); \
    KRD(GL,0); GAPB(o[0]=__builtin_amdgcn_mfma_f32_32x32x16_bf16(PAF(1),VFR(1),o[0],0,0,0), C0,8); \
    KRD(GL,1); GAPB(o[1]=__builtin_amdgcn_mfma_f32_32x32x16_bf16(PAF(1),VFR(5),o[1],0,0,0), C0,12); \
    KRD(GL,2); GAPB(o[0]=__builtin_amdgcn_mfma_f32_32x32x16_bf16(PAF(2),VFR(2),o[0],0,0,0), C1,0); \
    KRD(GL,3); GAPB(o[1]=__builtin_amdgcn_mfma_f32_32x32x16_bf16(PAF(2),VFR(6),o[1],0,0,0), C1,4); \
    GAPB(o[0]=__builtin_amdgcn_mfma_f32_32x32x16_bf16(PAF(3),VFR(3),o[0],0,0,0), C1,8); \
    GAPB(o[1]=__builtin_amdgcn_mfma_f32_32x32x16_bf16(PAF(3),VFR(7),o[1],0,0,0), C1,12); \
    }while(0)
  int t=1;
  #undef CMASK
  #define CMASK(P0,P1,t) do{}while(0)
  for(;t+5<NT;t+=2){
    STEP(pB0,pB1,pA0,pA1,t,true,true,true);     WAIT_BAR(2); RESC(); ROT();
    STEP(pA0,pA1,pB0,pB1,t+1,true,true,true);   WAIT_BAR(2); RESC(); ROT();
  }
  #undef CMASK
  #define CMASK(P0,P1,t) do{int jb_=(t)-(NT-4); if(SWA)wmask(P0,P1,jb_,qrel,hi); else if(jb_>=0)cmask(P0,P1,jb_,qrel,hi);}while(0)
  #define ENDW(tt) do{ if((tt)+3<NT){WAIT_BAR(2);} else if((tt)+2<NT){WAIT_BAR(1);} else {WAIT_BAR(0);} }while(0)
  for(;t+1<NT;t+=2){
    STEP(pB0,pB1,pA0,pA1,t,(t+3<NT),(t+1<NT),(t+1<NT));       ENDW(t);   RESC(); ROT();
    STEP(pA0,pA1,pB0,pB1,t+1,(t+4<NT),(t+2<NT),(t+2<NT));     ENDW(t+1); RESC(); ROT();
  }
  STEP(pB0,pB1,pA0,pA1,NT-1,false,false,false); RESC();
  { float sacc=pB0[0]+pB0[1]; _Pragma("unroll") for(int r=2;r<16;++r)sacc+=pB0[r]; _Pragma("unroll") for(int r=0;r<16;++r)sacc+=pB1[r]; l_reg+=sacc;
    pw0=(u32x4){PKW(pB0,0),PKW(pB0,2),PKW(pB0,4),PKW(pB0,6)};pw1=(u32x4){PKW(pB0,8),PKW(pB0,10),PKW(pB0,12),PKW(pB0,14)};pw2=(u32x4){PKW(pB1,0),PKW(pB1,2),PKW(pB1,4),PKW(pB1,6)};pw3=(u32x4){PKW(pB1,8),PKW(pB1,10),PKW(pB1,12),PKW(pB1,14)};
    SBAR(); pv(o,vb0+sl_cur,PAF(0),PAF(1),PAF(2),PAF(3)); }
  #undef PKW
  #undef PAF
  #undef VFR
  #undef PIN
  #undef MX3
  #undef GAPA
  #undef GAPB
  #undef EX
  #undef VRD
  #undef KRD
  #undef STEP
  #undef ENDW
  {auto rr=__builtin_amdgcn_permlane32_swap(__float_as_uint(l_reg),__float_as_uint(l_reg),false,false);l_reg=__uint_as_float(rr[0])+__uint_as_float(rr[1]);}
  if(hi==0)wsf[32+r32]=l_reg;asm volatile("s_waitcnt lgkmcnt(0)":::"memory");
  float rli[16];
  #pragma unroll
  for(int r=0;r<16;++r)rli[r]=__builtin_amdgcn_rcpf(wsf[32+crow(r,hi)]);
  bf16*Ow=Op+(long)(q0+wid*QBLK)*PO;
  { bf16*stg=(bf16*)(shm+LDS_OST)+wid*2048;
    #pragma unroll
    for(int r=0;r<16;++r){const int orow=crow(r,hi);
      #pragma unroll
      for(int d0=0;d0<2;++d0)stg[orow*64+d0*32+r32]=__float2bfloat16(o[d0][r]*rli[r]);}
    asm volatile("s_waitcnt lgkmcnt(0)":::"memory");
    #pragma unroll
    for(int i=0;i<4;++i){const int row=i*8+(lane>>3),ch=lane&7; const u32x4 v=*(const u32x4*)(stg+row*64+ch*8); ATTN_STORE16(Ow+(long)row*PO+ch*8,v);} }
  asm volatile("s_waitcnt lgkmcnt(0)\n\ts_barrier":::"memory");
  #undef DMA_K
  #undef DMA_V
  #undef CMASK
  #undef START
  #undef RESC
  #undef ROT
}
constexpr int ATTN_LDS_BYTES=LDS_BYTES;
#undef SBAR
#undef WAIT_BAR
}
constexpr int NWAVES = 8;
constexpr int TOK = 16384, SEQL = 4096, DMODEL = 2048, EVEN_IN = 4352, ODD_IN = 4096, DFF = 8192;
constexpr float EPSN = 1e-6f;
constexpr float LOG2E = 1.4426950408889634f;
constexpr size_t MiB = 1u << 20;
constexpr size_t WS_WIN = 1 * MiB, WS_WOUT = 18 * MiB, WS_W1 = 26 * MiB, WS_W2 = 58 * MiB, WS_WG = 90 * MiB;
constexpr size_t WS_H = 92 * MiB;
constexpr size_t WS_MIX = 156 * MiB;
constexpr size_t WS_CARRY = 220 * MiB;
constexpr size_t WS_R = 224 * MiB;
constexpr size_t WS_PROJ = WS_R;
constexpr size_t WS_ATT = WS_R + 136 * MiB;
constexpr size_t WS_MIXIN = WS_R + 200 * MiB;
constexpr size_t WS_Z = WS_R;
constexpr size_t WS_GATES = WS_R + 128 * MiB;
constexpr size_t WS_END = WS_R + 264 * MiB;
constexpr int LDS_BYTES = 147456;
constexpr int N_PHASES = 19;

typedef unsigned short bf16;
typedef unsigned v4u __attribute__((ext_vector_type(4)));
typedef unsigned v2u __attribute__((ext_vector_type(2)));
typedef float f32x4 __attribute__((ext_vector_type(4)));
#define LAS __attribute__((address_space(3)))
#define LDS_WAIT() asm volatile("s_waitcnt lgkmcnt(0)" ::: "memory")
__device__ __forceinline__ unsigned f2bf(float f) { unsigned u = __builtin_bit_cast(unsigned, f); return (u + 0x7fffu + ((u >> 16) & 1u)) >> 16; }
__device__ __forceinline__ unsigned pk2(float lo, float hi) { return f2bf(lo) | (f2bf(hi) << 16); }
__device__ __forceinline__ float bflo(unsigned w) { return __builtin_bit_cast(float, w << 16); }
__device__ __forceinline__ float bfhi(unsigned w) { return __builtin_bit_cast(float, w & 0xffff0000u); }
__device__ __forceinline__ float wave_sum(float v) {
#pragma unroll
    for (int o = 1; o < 64; o <<= 1) v += __shfl_xor(v, o);
    return v;
}
__device__ __forceinline__ float sigmoidf_(float x) { return __builtin_amdgcn_rcpf(1.f + __builtin_amdgcn_exp2f(-LOG2E * x)); }

__device__ __forceinline__ void transpose_item(const float* W, int K, int N, bf16* WT, int row_off, LAS float* scr, int item, int lane) {
    const int nblk = N / 32, kb = item / nblk, nb = item % nblk, k0 = 64 * kb, n0 = 32 * nb;
#pragma unroll 8
    for (int i = 0; i < 32; ++i) { const int kk = 2 * i + (lane >> 5); scr[kk * 33 + (lane & 31)] = W[(size_t)(k0 + kk) * N + n0 + (lane & 31)]; }
    LDS_WAIT(); asm volatile("" ::: "memory");
    const int c = lane & 7;
#pragma unroll
    for (int j = 0; j < 4; ++j) { const int n = (lane >> 3) + 8 * j; const LAS float* s = scr + (8 * c) * 33 + n;
        v4u o; o.x = pk2(s[0 * 33], s[1 * 33]); o.y = pk2(s[2 * 33], s[3 * 33]); o.z = pk2(s[4 * 33], s[5 * 33]); o.w = pk2(s[6 * 33], s[7 * 33]);
        *(v4u*)(WT + (size_t)(row_off + n0 + n) * K + k0 + 8 * c) = o; }
    LDS_WAIT(); asm volatile("" ::: "memory");
}

struct Params { const float* in[22]; float* out; unsigned char* ws; int lo, hi; };

__device__ __forceinline__ void convert_weights(const Params& p, int layer, LAS float* scr, int gw, int NGW, int lane) {
    unsigned char* ws = p.ws;
    const int I_IN = (layer == 0) ? 32 * (EVEN_IN / 32) : 32 * (ODD_IN / 32), I_OUT = 32 * 64, I_1 = 32 * 256, I_2 = 128 * 64, I_G = (layer == 0) ? 0 : 16 * 32;
    const int NIT = I_IN + I_OUT + I_1 + I_2 + I_G;
    const float* win = (layer == 0) ? p.in[1] : p.in[9]; const int nin = (layer == 0) ? EVEN_IN : ODD_IN;
    const float* wout = (layer == 0) ? p.in[8] : p.in[15];
    const float* w1 = p.in[20] + (size_t)layer * DMODEL * DFF; const float* w2 = p.in[21] + (size_t)layer * DFF * DMODEL;
    for (int it = gw; it < NIT; it += NGW) {
        int r = it;
        if (r < I_1) { transpose_item(w1, DMODEL, DFF, (bf16*)(ws + WS_W1), 0, scr, r, lane); continue; } r -= I_1;
        if (r < I_2) { transpose_item(w2, DFF, DMODEL, (bf16*)(ws + WS_W2), 0, scr, r, lane); continue; } r -= I_2;
        if (r < I_IN) { transpose_item(win, DMODEL, nin, (bf16*)(ws + WS_WIN), 0, scr, r, lane); continue; } r -= I_IN;
        if (r < I_OUT) { transpose_item(wout, DMODEL, DMODEL, (bf16*)(ws + WS_WOUT), 0, scr, r, lane); continue; } r -= I_OUT;
        { const int gn = r >> 5, g = gn >> 3, n = gn & 7;
          transpose_item(p.in[12] + (size_t)gn * 65536, 256, 256, (bf16*)(ws + WS_WG), n * 512 + g * 256, scr, r & 31, lane); }
    }
}

__device__ __forceinline__ void row_phase(const float* xin, const bf16* y, const float* gpost, float* xout, const float* gnext, bf16* hout, int gw, int NGW, int lane) {
    for (int m = gw; m < TOK; m += NGW) {
        const f32x4* xr = (const f32x4*)(xin + (size_t)m * DMODEL) + lane;
        f32x4 v[8];
#pragma unroll
        for (int j = 0; j < 8; ++j) v[j] = xr[64 * j];
        if (y) {
            const v2u* yr = (const v2u*)(y + (size_t)m * DMODEL) + lane; v2u yy[8]; float ss = 0.f;
#pragma unroll
            for (int j = 0; j < 8; ++j) { yy[j] = yr[64 * j]; const float a = bflo(yy[j].x), b = bfhi(yy[j].x), c = bflo(yy[j].y), d = bfhi(yy[j].y); ss += (a * a + b * b) + (c * c + d * d); }
            const float r = 1.0f / sqrtf(wave_sum(ss) * (1.f / DMODEL) + EPSN);
#pragma unroll
            for (int j = 0; j < 8; ++j) { const f32x4 g = ((const f32x4*)gpost)[64 * j + lane];
                v[j].x += bflo(yy[j].x) * r * g.x; v[j].y += bfhi(yy[j].x) * r * g.y; v[j].z += bflo(yy[j].y) * r * g.z; v[j].w += bfhi(yy[j].y) * r * g.w; }
        }
        if (xout) { f32x4* xo = (f32x4*)(xout + (size_t)m * DMODEL) + lane;
#pragma unroll
            for (int j = 0; j < 8; ++j) xo[64 * j] = v[j]; }
        if (hout) {
            float ss = 0.f;
#pragma unroll
            for (int j = 0; j < 8; ++j) ss += (v[j].x * v[j].x + v[j].y * v[j].y) + (v[j].z * v[j].z + v[j].w * v[j].w);
            const float r = 1.0f / sqrtf(wave_sum(ss) * (1.f / DMODEL) + EPSN);
            v2u* ho = (v2u*)(hout + (size_t)m * DMODEL) + lane;
#pragma unroll
            for (int j = 0; j < 8; ++j) { const f32x4 g = ((const f32x4*)gnext)[64 * j + lane]; v2u o; o.x = pk2(v[j].x * r * g.x, v[j].y * r * g.y); o.y = pk2(v[j].z * r * g.z, v[j].w * r * g.w); ho[64 * j] = o; }
        }
    }
}

__device__ __forceinline__ void diff_combine(const Params& p, int gw, int NGW, int lane) {
    const bf16* att = (const bf16*)(p.ws + WS_ATT); bf16* mixin = (bf16*)(p.ws + WS_MIXIN);
    const float s1 = wave_sum(p.in[2][lane] * p.in[3][lane]), s2 = wave_sum(p.in[4][lane] * p.in[5][lane]);
    const float lambda_init = 0.2f;
    const float lam = expf(s1) - expf(s2) + lambda_init;
    const int l16 = lane & 15, hsub = lane >> 4;
    float g[8];
#pragma unroll
    for (int k = 0; k < 8; ++k) g[k] = p.in[6][l16 * 8 + k] * (1.0f - lambda_init);
    for (int it = gw; it < TOK * 2; it += NGW) {
        const int t = it >> 1, h = (it & 1) * 4 + hsub;
        const v4u a = *(const v4u*)(att + (size_t)t * 2048 + 256 * h + l16 * 8), b = *(const v4u*)(att + (size_t)t * 2048 + 256 * h + 128 + l16 * 8);
        float v[8];
        v[0] = bflo(a.x) - lam * bflo(b.x); v[1] = bfhi(a.x) - lam * bfhi(b.x); v[2] = bflo(a.y) - lam * bflo(b.y); v[3] = bfhi(a.y) - lam * bfhi(b.y);
        v[4] = bflo(a.z) - lam * bflo(b.z); v[5] = bfhi(a.z) - lam * bfhi(b.z); v[6] = bflo(a.w) - lam * bflo(b.w); v[7] = bfhi(a.w) - lam * bfhi(b.w);
        float ss = 0.f;
#pragma unroll
        for (int k = 0; k < 8; ++k) ss += v[k] * v[k];
        ss += __shfl_xor(ss, 1); ss += __shfl_xor(ss, 2); ss += __shfl_xor(ss, 4); ss += __shfl_xor(ss, 8);
        const float r = 1.0f / sqrtf(ss * (1.f / 128.f) + EPSN);
        v4u o; o.x = pk2(v[0] * r * g[0], v[1] * r * g[1]); o.y = pk2(v[2] * r * g[2], v[3] * r * g[3]); o.z = pk2(v[4] * r * g[4], v[5] * r * g[5]); o.w = pk2(v[6] * r * g[6], v[7] * r * g[7]);
        *(v4u*)(mixin + (size_t)t * 2048 + 128 * h + l16 * 8) = o;
    }
}

__device__ __forceinline__ void conv_phase(const Params& p, int gtid, int NT) {
    const bf16* proj = (const bf16*)(p.ws + WS_PROJ); bf16* xc = (bf16*)(p.ws + WS_H);
    const float* cw = p.in[10]; const float* cb = p.in[11];
    for (int idx = gtid; idx < TOK * 256; idx += NT) {
        const int t = idx >> 8, ch = (idx & 255) * 8, s = t & (SEQL - 1);
        float acc[8];
        { const f32x4 b0 = *(const f32x4*)(cb + ch), b1 = *(const f32x4*)(cb + ch + 4); acc[0] = b0.x; acc[1] = b0.y; acc[2] = b0.z; acc[3] = b0.w; acc[4] = b1.x; acc[5] = b1.y; acc[6] = b1.z; acc[7] = b1.w; }
#pragma unroll
        for (int j = 0; j < 4; ++j) {
            if (s - 3 + j >= 0) {
                const v4u xv = *(const v4u*)(proj + (size_t)(t - 3 + j) * ODD_IN + 2048 + ch);
                const f32x4 w0 = *(const f32x4*)(cw + j * 2048 + ch), w1 = *(const f32x4*)(cw + j * 2048 + ch + 4);
                acc[0] += w0.x * bflo(xv.x); acc[1] += w0.y * bfhi(xv.x); acc[2] += w0.z * bflo(xv.y); acc[3] += w0.w * bfhi(xv.y);
                acc[4] += w1.x * bflo(xv.z); acc[5] += w1.y * bfhi(xv.z); acc[6] += w1.z * bflo(xv.w); acc[7] += w1.w * bfhi(xv.w);
            }
        }
        v4u o; o.x = pk2(acc[0], acc[1]); o.y = pk2(acc[2], acc[3]); o.z = pk2(acc[4], acc[5]); o.w = pk2(acc[6], acc[7]);
        *(v4u*)(xc + (size_t)t * 2048 + ch) = o;
    }
}

constexpr int SCH = 64, SLEN = SEQL / SCH;
template <int PASS> __device__ __forceinline__ void scan_phase(const Params& p, int gw, int NGW, int lane) {
    const bf16* gates = (const bf16*)(p.ws + WS_GATES); bf16* xc = (bf16*)(p.ws + WS_H); const bf16* proj = (const bf16*)(p.ws + WS_PROJ);
    float* cA = (float*)(p.ws + WS_CARRY); float* cH = cA + 4 * SCH * 2048;
    for (int it = gw; it < 4 * SCH * 8; it += NGW) {
        const int n = it & 7, c = (it >> 3) & (SCH - 1), b = it >> 9;
        const int ch = n * 256 + lane * 4;
        float sp8[4], b0[4], b1[4];
        { const f32x4 lm = *(const f32x4*)(p.in[14] + ch), g0 = *(const f32x4*)(p.in[13] + ch), g1 = *(const f32x4*)(p.in[13] + 2048 + ch);
#pragma unroll
          for (int k = 0; k < 4; ++k) { sp8[k] = -8.0f * LOG2E * log1pf(expf(-lm[k])); b0[k] = g0[k]; b1[k] = g1[k]; } }
        float h[4] = {0.f, 0.f, 0.f, 0.f}, ap[4] = {1.f, 1.f, 1.f, 1.f};
        if (PASS == 2) {
            for (int j = 0; j < c; ++j) { const f32x4 aj = *(const f32x4*)(cA + (size_t)(b * SCH + j) * 2048 + ch), hj = *(const f32x4*)(cH + (size_t)(b * SCH + j) * 2048 + ch);
#pragma unroll
                for (int k = 0; k < 4; ++k) h[k] = aj[k] * h[k] + hj[k]; }
        }
        const size_t t0 = (size_t)b * SEQL + (size_t)c * SLEN;
        const bf16* gp = gates + t0 * 4096 + n * 512 + lane * 4; bf16* xp = xc + t0 * 2048 + ch; const bf16* yp = proj + t0 * ODD_IN + ch;
#pragma unroll 4
        for (int s = 0; s < SLEN; ++s) {
            const v2u g0 = *(const v2u*)(gp + (size_t)s * 4096), g1 = *(const v2u*)(gp + (size_t)s * 4096 + 256), xv = *(const v2u*)(xp + (size_t)s * 2048);
            v2u yv; if (PASS == 2) yv = *(const v2u*)(yp + (size_t)s * ODD_IN);
            const float gg0[4] = {bflo(g0.x), bfhi(g0.x), bflo(g0.y), bfhi(g0.y)}, gg1[4] = {bflo(g1.x), bfhi(g1.x), bflo(g1.y), bfhi(g1.y)}, xx[4] = {bflo(xv.x), bfhi(xv.x), bflo(xv.y), bfhi(xv.y)};
            float o[4];
#pragma unroll
            for (int k = 0; k < 4; ++k) {
                const float r = sigmoidf_(gg0[k] + b0[k]), ig = sigmoidf_(gg1[k] + b1[k]);
                const float a = __builtin_amdgcn_exp2f(r * sp8[k]);
                const float u = sqrtf(fmaxf(1.0f - a * a, 0.f)) * (ig * xx[k]);
                h[k] = a * h[k] + u; ap[k] *= a; o[k] = h[k];
            }
            if (PASS == 2) { v2u ov; ov.x = pk2(o[0] * bflo(yv.x), o[1] * bfhi(yv.x)); ov.y = pk2(o[2] * bflo(yv.y), o[3] * bfhi(yv.y)); *(v2u*)(xp + (size_t)s * 2048) = ov; }
        }
        if (PASS == 1) { *(f32x4*)(cA + (size_t)(b * SCH + c) * 2048 + ch) = (f32x4){ap[0], ap[1], ap[2], ap[3]}; *(f32x4*)(cH + (size_t)(b * SCH + c) * 2048 + ch) = (f32x4){h[0], h[1], h[2], h[3]}; }
    }
}

__device__ __forceinline__ void attention_phase(const Params& p, char* lds, const int tid) {
    using abf = attn_body::bf16;
    const abf* proj = (const abf*)(p.ws + WS_PROJ); abf* att = (abf*)(p.ws + WS_ATT); abf* mixin = (abf*)(p.ws + WS_MIXIN);
    const int G = gridDim.x, c = blockIdx.x, nd = (2048 + G - 1) / G, ns = (1024 + G - 1) / G;
    for (int i = 0; i < nd + ns; ++i) {
        const abf *Qp, *Kp, *Vp; abf* Op; int q0, t0; bool swa; float sink_l2 = 0.f;
        if (i < nd) {
            const int pos = (i & 1) ? G - 1 - c : c, L = i * G + pos;
            if (L >= 2048) continue;
            const int qb = 15 - (L >> 7), combo = L & 127, b = combo >> 5, ic = combo & 31, hq = ic >> 1, cc = ic & 1;
            const abf* base = proj + (size_t)b * SEQL * EVEN_IN;
            Qp = base + hq * 64; Kp = base + 1024 + hq * 64; Vp = base + 2048 + (hq >> 1) * 128 + cc * 64; Op = att + (size_t)b * SEQL * 2048 + ic * 64; q0 = qb * 256; t0 = 0; swa = false;
        } else {
            const int L = (i - nd) * G + c; if (L >= 1024) continue;
            const int b = L >> 8, hq = (L >> 4) & 15, qb = L & 15;
            const abf* base = proj + (size_t)b * SEQL * EVEN_IN;
            sink_l2 = p.in[7][hq] * LOG2E;
            Qp = base + 3072 + hq * 64; Kp = base + 4096 + (hq >> 3) * 64; Vp = base + 4224 + (hq >> 3) * 64; Op = mixin + (size_t)b * SEQL * 2048 + 1024 + hq * 64; q0 = qb * 256; t0 = qb ? qb * 4 - 2 : 0; swa = true;
        }
        attn_body::attn_unit<8>(Qp, Kp, Vp, Op, q0, t0, swa, sink_l2, lds, tid);
    }
}

#ifndef MK_PER_PHASE
#define MK_PER_PHASE 0
#endif
__global__ void __launch_bounds__(NWAVES * 64, 2) mega_fwd(Params p) {
    extern __shared__ __attribute__((aligned(16))) unsigned char lds[];
    cg::grid_group grid = cg::this_grid();
    const int G = gridDim.x, NGW = G * NWAVES;
    const int lo = p.lo, hi = p.hi;
    unsigned char* ws = p.ws;
    bf16* H = (bf16*)(ws + WS_H); bf16* MIX = (bf16*)(ws + WS_MIX);
#define IN(k) (lo <= (k) && (k) < hi)
#define SEAM(k) do { if (IN(k) && IN((k) + 1)) grid.sync(); } while (0)
#define ROOTS() int tid = threadIdx.x; asm volatile("" : "+v"(tid)); const int lane = tid & 63, wave = __builtin_amdgcn_readfirstlane(tid >> 6); const int gw = blockIdx.x * NWAVES + wave; (void)lane; (void)gw
#define GEMM_PHASE(k, Aptr, LDA, Bptr, LDB, NN, KK, AGRP, Optr, LDC, MODE) do { if (IN(k)) { ROOTS(); \
        pg8::Gemm g; g.A = (Aptr); g.Bt = (Bptr); g.M = TOK; g.N = (NN); g.K = (KK); g.lda = (LDA); g.ldb = (LDB); g.agrp = (AGRP); \
        pg8::EpiAct E; E.O = (Optr); E.ldc = (LDC); E.mode = (MODE); \
        pg8::StaticOrder S; S.init(TOK, (NN), G, (int)blockIdx.x); \
        pg8::gemm_phase<pg8::EpiAct, pg8::StaticOrder, true, true>((PG8_LAS unsigned char*)lds, g, S, E, tid); } SEAM(k); } while (0)

    if (IN(0)) { ROOTS(); LAS float* scr = (LAS float*)((LAS unsigned char*)lds + wave * 16384);
        convert_weights(p, 0, scr, gw, NGW, lane); row_phase(p.in[0], nullptr, nullptr, nullptr, p.in[16], H, gw, NGW, lane); }
    SEAM(0);
    GEMM_PHASE(1, H, DMODEL, (bf16*)(ws + WS_WIN), DMODEL, EVEN_IN, DMODEL, 0, (bf16*)(ws + WS_PROJ), EVEN_IN, 3);
#ifndef NO_ATT
    if (IN(2)) { ROOTS(); attention_phase(p, (char*)lds, tid); }
#endif
    SEAM(2);
    if (IN(3)) { ROOTS(); diff_combine(p, gw, NGW, lane); }
    SEAM(3);
    GEMM_PHASE(4, (bf16*)(ws + WS_MIXIN), DMODEL, (bf16*)(ws + WS_WOUT), DMODEL, DMODEL, DMODEL, 0, MIX, DMODEL, 0);
    if (IN(5)) { ROOTS(); row_phase(p.in[0], MIX, p.in[17], p.out, p.in[18], H, gw, NGW, lane); }
    SEAM(5);
    GEMM_PHASE(6, H, DMODEL, (bf16*)(ws + WS_W1), DMODEL, DFF, DMODEL, 0, (bf16*)(ws + WS_Z), DFF, 1);
    GEMM_PHASE(7, (bf16*)(ws + WS_Z), DFF, (bf16*)(ws + WS_W2), DFF, DMODEL, DFF, 0, MIX, DMODEL, 0);
    if (IN(8)) { ROOTS(); LAS float* scr = (LAS float*)((LAS unsigned char*)lds + wave * 16384);
        convert_weights(p, 1, scr, gw, NGW, lane); row_phase(p.out, MIX, p.in[19], p.out, p.in[16] + DMODEL, H, gw, NGW, lane); }
    SEAM(8);
    GEMM_PHASE(9, H, DMODEL, (bf16*)(ws + WS_WIN), DMODEL, ODD_IN, DMODEL, 0, (bf16*)(ws + WS_PROJ), ODD_IN, 2);
    if (IN(10)) { ROOTS(); conv_phase(p, blockIdx.x * (NWAVES * 64) + tid, G * NWAVES * 64); }
    SEAM(10);
    GEMM_PHASE(11, H, DMODEL, (bf16*)(ws + WS_WG), 256, 4096, 256, 1, (bf16*)(ws + WS_GATES), 4096, 0);
#ifndef NO_SCAN
    if (IN(12)) { ROOTS(); scan_phase<1>(p, gw, NGW, lane); }
    SEAM(12);
    if (IN(13)) { ROOTS(); scan_phase<2>(p, gw, NGW, lane); }
    SEAM(13);
#endif
    GEMM_PHASE(14, H, DMODEL, (bf16*)(ws + WS_WOUT), DMODEL, DMODEL, DMODEL, 0, MIX, DMODEL, 0);
    if (IN(15)) { ROOTS(); row_phase(p.out, MIX, p.in[17] + DMODEL, p.out, p.in[18] + DMODEL, H, gw, NGW, lane); }
    SEAM(15);
    GEMM_PHASE(16, H, DMODEL, (bf16*)(ws + WS_W1), DMODEL, DFF, DMODEL, 0, (bf16*)(ws + WS_Z), DFF, 1);
    GEMM_PHASE(17, (bf16*)(ws + WS_Z), DFF, (bf16*)(ws + WS_W2), DFF, DMODEL, DFF, 0, MIX, DMODEL, 0);
    if (IN(18)) { ROOTS(); row_phase(p.out, MIX, p.in[19] + DMODEL, p.out, nullptr, nullptr, gw, NGW, lane); }
#undef IN
#undef SEAM
#undef ROOTS
#undef GEMM_PHASE
}

extern "C" void kernel_launch(void* const* d_in, const int* in_sizes, int n_in, void* d_out, int out_size, void* d_ws, size_t ws_size, hipStream_t stream) {
    static int grid = 0;
    if (grid == 0) {
        if (n_in != 22 || in_sizes[0] != TOK * DMODEL || out_size != TOK * DMODEL || ws_size < WS_END) { fprintf(stderr, "kernel_launch: unexpected shapes / workspace (n_in %d, in0 %d, out %d, ws %zu)\n", n_in, n_in > 0 ? in_sizes[0] : -1, out_size, ws_size); grid = -1; return; }
        int dev = 0, cus = 0, per_cu = 0;
        if (hipGetDevice(&dev) != hipSuccess || hipDeviceGetAttribute(&cus, hipDeviceAttributeMultiprocessorCount, dev) != hipSuccess) { grid = -1; return; }
        if (hipFuncSetAttribute((const void*)mega_fwd, hipFuncAttributeMaxDynamicSharedMemorySize, LDS_BYTES) != hipSuccess) { fprintf(stderr, "kernel_launch: hipFuncSetAttribute failed\n"); grid = -1; return; }
        if (hipOccupancyMaxActiveBlocksPerMultiprocessor(&per_cu, (const void*)mega_fwd, NWAVES * 64, LDS_BYTES) != hipSuccess || per_cu < 1) { per_cu = 1; (void)hipGetLastError(); }
        grid = cus * per_cu;
    }
    if (grid < 0) return;
    Params p{};
    for (int i = 0; i < 22; ++i) p.in[i] = (const float*)d_in[i];
    p.out = (float*)d_out; p.ws = (unsigned char*)d_ws;
#if MK_PER_PHASE
    for (int ph = 0; ph < N_PHASES; ++ph) {
        p.lo = ph; p.hi = ph + 1; void* args[] = {&p};
        hipError_t e = hipLaunchCooperativeKernel((const void*)mega_fwd, dim3(grid), dim3(NWAVES * 64), args, LDS_BYTES, stream);
        if (e != hipSuccess) { fprintf(stderr, "cooperative launch failed: %s (grid %d)\n", hipGetErrorString(e), grid); break; }
    }
#else
    p.lo = 0; p.hi = N_PHASES; void* args[] = {&p};
    hipError_t e = hipLaunchCooperativeKernel((const void*)mega_fwd, dim3(grid), dim3(NWAVES * 64), args, LDS_BYTES, stream);
    if (e != hipSuccess) fprintf(stderr, "cooperative launch failed: %s (grid %d)\n", hipGetErrorString(e), grid);
#endif
}
```

```cpp
#include <hip/hip_runtime.h>
#include <hip/hip_cooperative_groups.h>
#include <cstdio>
#include <cstdint>
namespace cg = cooperative_groups;
namespace pg8 {
#define PG8_LAS __attribute__((address_space(3)))
typedef unsigned short bf16_t;
typedef short bf16x8 __attribute__((ext_vector_type(8)));
typedef float f32x4 __attribute__((ext_vector_type(4)));
typedef unsigned u32x4 __attribute__((ext_vector_type(4)));
constexpr int BM = 256, BK = 64, HALF = 128, HTB = HALF * BK * 2  , STAGE_BYTES = 8 * HTB, NXCD = 8, WGM = 8;

__host__ __device__ __forceinline__ int lds_byte(int r, int c) { const int st = (r >> 4) * 2 + (c >> 5), rr = r & 15, cc = c & 31, ob = rr * 64 + cc * 2; return st * 1024 + (ob ^ (((ob >> 9) & 1) << 5)); }
__host__ __device__ __forceinline__ void stage_rc(int b, int& R, int& C) { const int st = b / 1024, sb = b % 1024, swz = sb ^ (((sb >> 9) & 1) << 5); R = (st >> 1) * 16 + swz / 64; C = (st & 1) * 32 + (swz % 64) / 2; }
__host__ __device__ __forceinline__ int perm32(int rho) { const int n = rho >> 4, i = rho & 15; return 8 * (i >> 2) + 4 * n + (i & 3); }

struct Unit { int pm, pn; };
struct Gemm { const bf16_t* A; const bf16_t* Bt; int M, N, K, lda, ldb, agrp; };

struct StaticOrder {
    int nM, nN, nwg, G, c, wgm;
    __host__ __device__ void init(int M, int N, int G_, int c_) { nM = M / BM; nN = N / BM; nwg = nM * nN; G = G_; c = c_; wgm = WGM; }
    __host__ __device__ bool next(int i, Unit& u) const {
        const long L = (long)i * G + c; if (L >= nwg) return false;
        int wgid = (int)L; { const int q = nwg / NXCD, r = nwg % NXCD, xcd = wgid % NXCD, off = wgid / NXCD; wgid = (xcd < r ? xcd * (q + 1) : r * (q + 1) + (xcd - r) * q) + off; }
        const int nig = wgm * nN, gid = wgid / nig, fm = gid * wgm, gsz = (nM - fm) < wgm ? (nM - fm) : wgm;
        u.pm = fm + ((wgid % nig) % gsz); u.pn = (wgid % nig) / gsz; return true;
    }
    __device__ __forceinline__ void a_ready(const Unit&) const {}
    __device__ __forceinline__ void done(const Unit&) const {}
};

__device__ __forceinline__ unsigned cvt_pk_bf16(float lo, float hi) { unsigned r; asm volatile("v_cvt_pk_bf16_f32 %0, %1, %2" : "=v"(r) : "v"(lo), "v"(hi)); return r; }
__device__ __forceinline__ float act_gelu_tanh(float v) {
    const float u = v * (1.5957691216f + 0.0713548163f * v * v);
    return v * __builtin_amdgcn_rcpf(1.f + __builtin_amdgcn_exp2f(-1.4426950409f * u));
}
constexpr float QSCALE = 0.125f * 1.4426950408889634f;
struct EpiAct {
    static constexpr bool PERM = true, AFTER_DRAIN = false;
    bf16_t* O; int ldc; int mode; const float* rs;
    __device__ __forceinline__ void operator()(const f32x4 (&acc)[2][2][4][2], const Unit& u, int wr, int wc, int fr, int fq) const {
        const int row0 = u.pm * BM + wr * 64 + fr, col0 = u.pn * BM + wc * 32 + 8 * fq;
        int md = mode; float sc = 1.f;
        if (md == 2 && u.pn >= 8) md = 0;
        if (md == 3) { md = 0; if (u.pn < 4 || (u.pn >= 12 && u.pn < 16)) sc = QSCALE; }
#pragma unroll
        for (int ai = 0; ai < 2; ++ai)
#pragma unroll
            for (int m = 0; m < 4; ++m) { bf16_t* rowp = O + (size_t)(row0 + ai * HALF + m * 16) * ldc + col0; const float rsc = rs ? 1.0f / sqrtf(rs[row0 + ai * HALF + m * 16] * (1.0f / 2048.0f) + 1e-6f) : 1.0f;
#pragma unroll
                for (int bj = 0; bj < 2; ++bj) { f32x4 v0 = acc[ai][bj][m][0] * rsc, v1 = acc[ai][bj][m][1] * rsc;
                    if (md == 1) {
#pragma unroll
                        for (int e = 0; e < 4; ++e) { const float a = fmaxf(v0[e], 0.f), b = fmaxf(v1[e], 0.f); v0[e] = a * a; v1[e] = b * b; }
                    } else if (md == 2) {
#pragma unroll
                        for (int e = 0; e < 4; ++e) { v0[e] = act_gelu_tanh(v0[e]); v1[e] = act_gelu_tanh(v1[e]); }
                    }
                    v0 = v0 * sc; v1 = v1 * sc; u32x4 w; w.x = cvt_pk_bf16(v0[0], v0[1]); w.y = cvt_pk_bf16(v0[2], v0[3]); w.z = cvt_pk_bf16(v1[0], v1[1]); w.w = cvt_pk_bf16(v1[2], v1[3]);
                    *(u32x4*)(rowp + bj * HALF) = w; } }
    }
};

struct EpiResNorm {
    static constexpr bool PERM = true, AFTER_DRAIN = false;
    bf16_t* XB; const float* gpost; float* ssq_out; float* out_f32; float* xbuf; unsigned* cnt; PG8_LAS unsigned char* ldsx;
    __device__ __forceinline__ void operator()(f32x4 (&acc)[2][2][4][2], const Unit& u, int wr, int wc, int fr, int fq) const {
        const int wid = wr * 4 + wc, lane = fq * 16 + fr;
        PG8_LAS float* P = (PG8_LAS float*)ldsx;
        PG8_LAS float* S = (PG8_LAS float*)(ldsx + 4096);
        const int colb = u.pn * BM + wc * 32 + 8 * fq;
#pragma unroll
        for (int ai = 0; ai < 2; ++ai)
#pragma unroll
            for (int m = 0; m < 4; ++m) { float s = 0.f;
#pragma unroll
                for (int bj = 0; bj < 2; ++bj)
#pragma unroll
                    for (int n = 0; n < 2; ++n) { const f32x4 x = acc[ai][bj][m][n]; s += (x[0] * x[0] + x[1] * x[1]) + (x[2] * x[2] + x[3] * x[3]); }
                s += __shfl_xor(s, 16); s += __shfl_xor(s, 32);
                if (fq == 0) P[(ai * HALF + wr * 64 + m * 16 + fr) * 4 + wc] = s; }
        asm volatile("s_waitcnt lgkmcnt(0)" ::: "memory"); __builtin_amdgcn_s_barrier(); asm volatile("" ::: "memory");
        const int row = wid * 32 + (lane & 31);
        if (lane < 32) { const float t = (P[row * 4 + 0] + P[row * 4 + 1]) + (P[row * 4 + 2] + P[row * 4 + 3]);
            __hip_atomic_store(xbuf + (size_t)(u.pm * BM + row) * 8 + u.pn, t, __ATOMIC_RELAXED, __HIP_MEMORY_SCOPE_AGENT); }
        asm volatile("s_waitcnt vmcnt(0)" ::: "memory");
        if (lane == 0) __hip_atomic_fetch_add(cnt + 16 * u.pm, 1u, __ATOMIC_RELAXED, __HIP_MEMORY_SCOPE_AGENT);
        u32x4 xbv[4][2];
#pragma unroll
        for (int m = 0; m < 4; ++m)
#pragma unroll
            for (int bj = 0; bj < 2; ++bj) xbv[m][bj] = *(const u32x4*)(XB + (size_t)(u.pm * BM + wr * 64 + m * 16 + fr) * 2048 + colb + bj * HALF);
        if (wid == 0) { unsigned sp = 0;
#ifdef PROBE_POLL
            const unsigned tp0_ = (unsigned)__builtin_amdgcn_s_memrealtime();
#endif
            while ((unsigned)__builtin_amdgcn_readfirstlane(__hip_atomic_load(cnt + 16 * u.pm, __ATOMIC_RELAXED, __HIP_MEMORY_SCOPE_AGENT)) < 64u) { __builtin_amdgcn_s_sleep(2); if (++sp > (1u << 22)) break; }
            __builtin_amdgcn_fence(__ATOMIC_ACQUIRE, "agent");
#ifdef PROBE_POLL
            if (lane == 0) ((volatile PG8_LAS unsigned*)(ldsx + 6144))[0] += (unsigned)__builtin_amdgcn_s_memrealtime() - tp0_;
#endif
            }
        asm volatile("s_waitcnt vmcnt(0) lgkmcnt(0)" ::: "memory"); __builtin_amdgcn_s_barrier(); asm volatile("" ::: "memory");
        { const int tid_ = wid * 64 + lane, row2 = tid_ >> 1; const float* slot = xbuf + (size_t)(u.pm * BM + row2) * 8 + (tid_ & 1) * 4; float tot = 0.f;
#pragma unroll
            for (int t = 0; t < 4; ++t) tot += __hip_atomic_load(slot + t, __ATOMIC_RELAXED, __HIP_MEMORY_SCOPE_AGENT);
            tot += __shfl_xor(tot, 1);
            if ((tid_ & 1) == 0) S[row2] = 1.0f / sqrtf(tot * (1.0f / 2048.0f) + 1e-6f); }
        asm volatile("s_waitcnt lgkmcnt(0)" ::: "memory"); __builtin_amdgcn_s_barrier(); asm volatile("" ::: "memory");
        f32x4 gv[2][2];
#pragma unroll
        for (int bj = 0; bj < 2; ++bj) { gv[bj][0] = *(const f32x4*)(gpost + colb + bj * HALF); gv[bj][1] = *(const f32x4*)(gpost + colb + bj * HALF + 4); }
        float ssv[2][4];
#define PG8_X1(ai) do { _Pragma("unroll") for (int m = 0; m < 4; ++m) { const float r = S[(ai) * HALF + wr * 64 + m * 16 + fr]; float ss = 0.f; \
            _Pragma("unroll") for (int bj = 0; bj < 2; ++bj) { const u32x4 xb = xbv[m][bj]; f32x4 v0 = acc[ai][bj][m][0] * r * gv[bj][0], v1 = acc[ai][bj][m][1] * r * gv[bj][1]; \
                v0[0] += __builtin_bit_cast(float, xb.x << 16); v0[1] += __builtin_bit_cast(float, xb.x & 0xffff0000u); v0[2] += __builtin_bit_cast(float, xb.y << 16); v0[3] += __builtin_bit_cast(float, xb.y & 0xffff0000u); \
                v1[0] += __builtin_bit_cast(float, xb.z << 16); v1[1] += __builtin_bit_cast(float, xb.z & 0xffff0000u); v1[2] += __builtin_bit_cast(float, xb.w << 16); v1[3] += __builtin_bit_cast(float, xb.w & 0xffff0000u); \
                ss += (v0[0] * v0[0] + v0[1] * v0[1]) + (v0[2] * v0[2] + v0[3] * v0[3]) + (v1[0] * v1[0] + v1[1] * v1[1]) + (v1[2] * v1[2] + v1[3] * v1[3]); \
                acc[ai][bj][m][0] = v0; acc[ai][bj][m][1] = v1; } \
            ss += __shfl_xor(ss, 16); ss += __shfl_xor(ss, 32); ssv[ai][m] = ss; } } while (0)
#define PG8_ST(ai) do { _Pragma("unroll") for (int m = 0; m < 4; ++m) { const size_t grow = (size_t)(u.pm * BM + (ai) * HALF + wr * 64 + m * 16 + fr); \
            _Pragma("unroll") for (int bj = 0; bj < 2; ++bj) { const f32x4 v0 = acc[ai][bj][m][0], v1 = acc[ai][bj][m][1]; \
                if (out_f32) { float* op = out_f32 + grow * 2048 + colb + bj * HALF; __builtin_nontemporal_store(v0, (f32x4*)op); __builtin_nontemporal_store(v1, (f32x4*)(op + 4)); } \
                else { u32x4 w; w.x = cvt_pk_bf16(v0[0], v0[1]); w.y = cvt_pk_bf16(v0[2], v0[3]); w.z = cvt_pk_bf16(v1[0], v1[1]); w.w = cvt_pk_bf16(v1[2], v1[3]); *(u32x4*)(XB + grow * 2048 + colb + bj * HALF) = w; } } } } while (0)
        PG8_X1(0);
#pragma unroll
        for (int m = 0; m < 4; ++m)
#pragma unroll
            for (int bj = 0; bj < 2; ++bj) xbv[m][bj] = *(const u32x4*)(XB + (size_t)(u.pm * BM + HALF + wr * 64 + m * 16 + fr) * 2048 + colb + bj * HALF);
        asm volatile("" ::: "memory");
        PG8_ST(0);
        PG8_X1(1);
        PG8_ST(1);
        if (!out_f32 && fq == 0) {
#pragma unroll
            for (int ai = 0; ai < 2; ++ai)
#pragma unroll
                for (int m = 0; m < 4; ++m) atomicAdd(ssq_out + (size_t)(u.pm * BM + ai * HALF + wr * 64 + m * 16 + fr), ssv[ai][m]); }
#undef PG8_X1
#undef PG8_ST
        asm volatile("s_waitcnt vmcnt(0)" ::: "memory");
    }
};
template <class Epi, class Sched, bool ALIGN_EPI = false, bool SP2 = false>
__device__ __forceinline__ void gemm_phase(PG8_LAS unsigned char* lds, const Gemm g, const Sched& S, const Epi& E, const int tid) {
    const int wid = __builtin_amdgcn_readfirstlane(tid >> 6), lane = tid & 63, wr = wid >> 2, wc = wid & 3, fr = lane & 15, fq = lane >> 4;
    const int K = g.K, nt = K / BK;
    unsigned voffA[2], voffB[2];
#pragma unroll
    for (int i = 0; i < 2; ++i) { int R, C; stage_rc(tid * 16 + i * 8192, R, C); const int Rb = Epi::PERM ? ((R & ~31) + perm32(R & 31)) : R;
        voffA[i] = (unsigned)(R * g.lda + C) * 2u; voffB[i] = (unsigned)(Rb * g.ldb + C) * 2u; }
    const size_t kstep = (size_t)(BK * 2);
    const size_t hstepA = (size_t)HALF * g.lda * 2, hstepB = (size_t)HALF * g.ldb * 2;
    const size_t tstepA = 2 * hstepA, tstepB = 2 * hstepB; const size_t agk = g.agrp ? (size_t)K * 2 : 0;
    const unsigned ldsw = (unsigned)wid * 1024u;
    const int aoff = lds_byte(wr * 64 + fr, fq * 8), boff = lds_byte(wc * 32 + fr, fq * 8);
#define PG8_SA(b, h) (((b) * 2 + (h)) * HTB)
#define PG8_SB(b, h) ((4 + (b) * 2 + (h)) * HTB)
#define PG8_STAGE(bufoff, gbase, voff) do { _Pragma("unroll") for (int _i = 0; _i < 2; ++_i) \
        __builtin_amdgcn_global_load_lds((const unsigned*)((const char*)(gbase) + (voff)[_i]), (PG8_LAS unsigned*)(lds + (bufoff) + ldsw + _i * 8192), 16, 0, 0); } while (0)
#define PG8_LDA(dst, b, h) do { _Pragma("unroll") for (int m = 0; m < 4; ++m) _Pragma("unroll") for (int k = 0; k < 2; ++k) dst[m][k] = *(const PG8_LAS bf16x8*)(lds + PG8_SA(b, h) + aoff + m * 2048 + k * 1024); } while (0)
#define PG8_LDB(dst, b, h) do { _Pragma("unroll") for (int n = 0; n < 2; ++n) _Pragma("unroll") for (int k = 0; k < 2; ++k) dst[n][k] = *(const PG8_LAS bf16x8*)(lds + PG8_SB(b, h) + boff + n * 2048 + k * 1024); } while (0)
#define PG8_MMA(ai, bj, At, Bt) do { __builtin_amdgcn_s_setprio(1); _Pragma("unroll") for (int m = 0; m < 4; ++m) _Pragma("unroll") for (int n = 0; n < 2; ++n) _Pragma("unroll") for (int k = 0; k < 2; ++k) \
        acc[ai][bj][m][n] = __builtin_amdgcn_mfma_f32_16x16x32_bf16(Bt[n][k], At[m][k], acc[ai][bj][m][n], 0, 0, 0); __builtin_amdgcn_s_setprio(0); } while (0)
#define PG8_WAIT_V(n) asm volatile("s_waitcnt vmcnt(" #n ")" ::: "memory")
#define PG8_WAIT_L(n) asm volatile("s_waitcnt lgkmcnt(" #n ")" ::: "memory")
#define PG8_BAR __builtin_amdgcn_s_barrier()
#define PG8_SCHED __builtin_amdgcn_sched_barrier(0)
    Unit cur, nxt; int ui = 0;
    if (!S.next(0, cur)) return;
    f32x4 acc[2][2][4][2];
#pragma unroll
    for (int a = 0; a < 2; ++a)
#pragma unroll
        for (int b = 0; b < 2; ++b)
#pragma unroll
            for (int m = 0; m < 4; ++m)
#pragma unroll
                for (int n = 0; n < 2; ++n) acc[a][b][m][n] = (f32x4){0.f, 0.f, 0.f, 0.f};
    bf16x8 At[4][2], B0[2][2], B1[2][2];
    const char* cA = (const char*)g.A + (size_t)cur.pm * tstepA + (size_t)(cur.pn >> 1) * agk; const char* cB = (const char*)g.Bt + (size_t)cur.pn * tstepB;
    S.a_ready(cur);
    if constexpr (SP2) {
        PG8_STAGE(PG8_SB(0, 0), cB, voffB); PG8_STAGE(PG8_SB(0, 1), cB + hstepB, voffB); PG8_STAGE(PG8_SA(0, 0), cA, voffA); PG8_STAGE(PG8_SA(0, 1), cA + hstepA, voffA);
        if (wr == 1) PG8_BAR;
        PG8_WAIT_V(2); PG8_BAR;
        PG8_STAGE(PG8_SB(1, 0), cB + kstep, voffB); PG8_STAGE(PG8_SA(1, 0), cA + kstep, voffA); PG8_STAGE(PG8_SB(1, 1), cB + hstepB + kstep, voffB);
        PG8_WAIT_V(6); PG8_BAR;
    } else {
        PG8_STAGE(PG8_SB(0, 0), cB, voffB); PG8_STAGE(PG8_SA(0, 0), cA, voffA); PG8_STAGE(PG8_SB(0, 1), cB + hstepB, voffB); PG8_STAGE(PG8_SA(0, 1), cA + hstepA, voffA);
        if (wr == 1) PG8_BAR;
        PG8_WAIT_V(4); PG8_BAR;
        PG8_STAGE(PG8_SB(1, 0), cB + kstep, voffB); PG8_STAGE(PG8_SA(1, 0), cA + kstep, voffA); PG8_STAGE(PG8_SB(1, 1), cB + hstepB + kstep, voffB);
        PG8_WAIT_V(6); PG8_BAR;
    }
    for (;;) {
        const bool has_next = S.next(ui + 1, nxt);
        const char* nA = has_next ? (const char*)g.A + (size_t)nxt.pm * tstepA + (size_t)(nxt.pn >> 1) * agk : cA; const char* nB = has_next ? (const char*)g.Bt + (size_t)nxt.pn * tstepB : cB;
        for (int t = 0; t < nt; t += 2) {
            const bool last = (t == nt - 2);
            const char* a1 = cA + (size_t)(t + 1) * kstep;
            const char* a2 = last ? nA : cA + (size_t)(t + 2) * kstep; const char* b2 = last ? nB : cB + (size_t)(t + 2) * kstep;
            const char* a3 = a2 + kstep; const char* b3 = b2 + kstep;
            if (last && has_next) S.a_ready(nxt);
            if constexpr (SP2) {
            PG8_LDB(B0, 0, 0); PG8_LDB(B1, 0, 1); PG8_SCHED; PG8_LDA(At, 0, 0); PG8_STAGE(PG8_SA(1, 1), a1 + hstepA, voffA);
            PG8_WAIT_V(8); PG8_WAIT_L(0); PG8_BAR; PG8_MMA(0, 0, At, B0); PG8_MMA(0, 1, At, B1); PG8_BAR; PG8_SCHED;
            PG8_LDA(At, 0, 1); PG8_STAGE(PG8_SB(0, 0), b2, voffB); PG8_STAGE(PG8_SB(0, 1), b2 + hstepB, voffB); PG8_STAGE(PG8_SA(0, 0), a2, voffA);
            PG8_WAIT_V(8); PG8_WAIT_L(0); PG8_BAR; PG8_MMA(1, 0, At, B0); PG8_MMA(1, 1, At, B1); PG8_BAR; PG8_SCHED;
            PG8_LDB(B0, 1, 0); PG8_LDB(B1, 1, 1); PG8_SCHED; PG8_LDA(At, 1, 0); PG8_STAGE(PG8_SA(0, 1), a2 + hstepA, voffA);
            PG8_WAIT_V(8); PG8_WAIT_L(0); PG8_BAR; PG8_MMA(0, 0, At, B0); PG8_MMA(0, 1, At, B1); PG8_BAR; PG8_SCHED;
            PG8_LDA(At, 1, 1); PG8_STAGE(PG8_SB(1, 0), b3, voffB); PG8_STAGE(PG8_SB(1, 1), b3 + hstepB, voffB); PG8_STAGE(PG8_SA(1, 0), a3, voffA);
            PG8_WAIT_V(8); PG8_WAIT_L(0); PG8_BAR; PG8_MMA(1, 0, At, B0); PG8_MMA(1, 1, At, B1); PG8_BAR; PG8_SCHED;
            } else {
            PG8_LDB(B0, 0, 0); PG8_SCHED; PG8_LDA(At, 0, 0); PG8_STAGE(PG8_SA(1, 1), a1 + hstepA, voffA);
            PG8_WAIT_L(8); PG8_BAR; PG8_WAIT_L(0); PG8_MMA(0, 0, At, B0); PG8_BAR; PG8_SCHED;
            PG8_LDB(B1, 0, 1); PG8_STAGE(PG8_SB(0, 0), b2, voffB);
            PG8_BAR; PG8_WAIT_L(0); PG8_MMA(0, 1, At, B1); PG8_BAR;
            PG8_LDA(At, 0, 1); PG8_STAGE(PG8_SA(0, 0), a2, voffA);
            PG8_BAR; PG8_WAIT_L(0); PG8_MMA(1, 0, At, B0); PG8_BAR; PG8_SCHED;
            PG8_STAGE(PG8_SB(0, 1), b2 + hstepB, voffB);
            PG8_WAIT_V(6); PG8_BAR; PG8_MMA(1, 1, At, B1); PG8_BAR;
            PG8_LDB(B0, 1, 0); PG8_SCHED; PG8_LDA(At, 1, 0); PG8_STAGE(PG8_SA(0, 1), a2 + hstepA, voffA);
            PG8_WAIT_L(8); PG8_BAR; PG8_WAIT_L(0); PG8_MMA(0, 0, At, B0); PG8_BAR; PG8_SCHED;
            PG8_LDB(B1, 1, 1); PG8_STAGE(PG8_SB(1, 0), b3, voffB);
            PG8_BAR; PG8_WAIT_L(0); PG8_MMA(0, 1, At, B1); PG8_BAR;
            PG8_LDA(At, 1, 1); PG8_STAGE(PG8_SA(1, 0), a3, voffA);
            PG8_BAR; PG8_WAIT_L(0); PG8_MMA(1, 0, At, B0); PG8_BAR; PG8_SCHED;
            PG8_STAGE(PG8_SB(1, 1), b3 + hstepB, voffB);
            PG8_WAIT_V(6); PG8_BAR; PG8_MMA(1, 1, At, B1); PG8_BAR;
            }
        }
        if constexpr (ALIGN_EPI) { if (wr == 0) PG8_BAR; }
        if constexpr (!Epi::AFTER_DRAIN) { E(acc, cur, wr, wc, fr, fq); S.done(cur); }
        if (!has_next) break;
#pragma unroll
        for (int a = 0; a < 2; ++a)
#pragma unroll
            for (int b = 0; b < 2; ++b)
#pragma unroll
                for (int m = 0; m < 4; ++m)
#pragma unroll
                    for (int n = 0; n < 2; ++n) acc[a][b][m][n] = (f32x4){0.f, 0.f, 0.f, 0.f};
        cur = nxt; cA = nA; cB = nB; ++ui;
        if constexpr (ALIGN_EPI) { if (wr == 1) PG8_BAR; }
    }
    PG8_WAIT_V(0);
    if constexpr (!ALIGN_EPI) { if (wr == 0) PG8_BAR; }
    PG8_BAR;
    if constexpr (Epi::AFTER_DRAIN) { E.fused(acc, cur, wr, wc, fr, fq, lds, wid, lane); S.done(cur); }
#undef PG8_SA
#undef PG8_SB
#undef PG8_STAGE
#undef PG8_LDA
#undef PG8_LDB
#undef PG8_MMA
#undef PG8_WAIT_V
#undef PG8_WAIT_L
#undef PG8_BAR
#undef PG8_SCHED
}
}
#include <hip/hip_bf16.h>
#include <cmath>
namespace attn_body {
using bf16=__hip_bfloat16;
using bf16x8=__attribute__((ext_vector_type(8)))short;
using s16x4=__attribute__((ext_vector_type(4)))short;
using f32x16=__attribute__((ext_vector_type(16)))float;
using u32x4=__attribute__((ext_vector_type(4)))unsigned;
constexpr int D=64,DM=4352,PO=2048;
constexpr int NW=8,QBLK=32,QB=QBLK*NW,KVBLK=64;
__device__ __forceinline__ int crow(int r,int hi){return (r&3)+8*(r>>2)+4*hi;}
#define SBAR() __builtin_amdgcn_sched_barrier(0)
__device__ __forceinline__ void cmask(f32x16&p0,f32x16&p1,int jb,int qrel,int hi){
  const float NEG=-INFINITY; int kb=64*jb+4*hi;
  #pragma unroll
  for(int r=0;r<16;++r){int kv=kb+(r&3)+8*(r>>2); if(kv>qrel)p0[r]=NEG; if(kv+32>qrel)p1[r]=NEG;}
}

__device__ __forceinline__ void wmask(f32x16&p0,f32x16&p1,int jb,int qrel,int hi){
  const float NEG=-INFINITY; int kb=64*jb+4*hi;
  #pragma unroll
  for(int r=0;r<16;++r){const int dd=qrel-kb-((r&3)+8*(r>>2)); if((unsigned)dd>127u)p0[r]=NEG; if((unsigned)(dd-32)>127u)p1[r]=NEG;}
}
constexpr int NSLOT=3, SLOTB=8192;
constexpr int LDS_K=0, LDS_V=NSLOT*SLOTB, LDS_WS=2*NSLOT*SLOTB, LDS_OST=LDS_WS+NW*64*4, LDS_BYTES=LDS_OST+NW*4096;
constexpr float C2=0.125f*1.4426950408889634f;
__device__ __forceinline__ void glds16(const void*gsrc,unsigned lds_dst){unsigned keep;
  asm volatile("s_mov_b32 %0, m0\n\ts_mov_b32 m0, %2\n\ts_nop 0\n\tglobal_load_lds_dwordx4 %1, off\n\ts_mov_b32 m0, %0":"=&s"(keep):"v"(gsrc),"s"(lds_dst):"memory");}
__device__ __forceinline__ float max3f(float a,float b,float c){float r;asm("v_max3_f32 %0, %1, %2, %3":"=v"(r):"v"(a),"v"(b),"v"(c));return r;}
__device__ __forceinline__ float max2f(float a,float b){float r;asm("v_max_f32_e32 %0, %1, %2":"=v"(r):"v"(a),"v"(b));return r;}
__device__ __forceinline__ float fadd_s(float a,float b){float r;asm("v_add_f32_e32 %0, %1, %2":"=v"(r):"v"(a),"v"(b));return r;}
__device__ __forceinline__ float fsub_s(float a,float b){float r;asm("v_sub_f32_e32 %0, %1, %2":"=v"(r):"v"(a),"v"(b));return r;}
typedef float f32x2_t __attribute__((ext_vector_type(2))); typedef __bf16 bf16x2_t __attribute__((ext_vector_type(2)));
__device__ __forceinline__ unsigned cvtpk_s(float lo,float hi){f32x2_t v={lo,hi};bf16x2_t b=__builtin_convertvector(v,bf16x2_t);return __builtin_bit_cast(unsigned,b);}
#define WAIT_BAR(N) asm volatile("s_waitcnt vmcnt(" #N ") lgkmcnt(0)\n\ts_barrier":::"memory")

__device__ __forceinline__ void qkt(f32x16&p0,f32x16&p1,const char*Kslot,const bf16x8*qr,const f32x16&negm,int r32,int hi){
  const char*kb=Kslot+hi*1024+r32*16;
  #pragma unroll
  for(int d0=0;d0<4;++d0){
    const bf16x8 b0=*reinterpret_cast<const bf16x8*>(kb+d0*2048);
    const bf16x8 b1=*reinterpret_cast<const bf16x8*>(kb+d0*2048+512);
    if(d0==0){p0=__builtin_amdgcn_mfma_f32_32x32x16_bf16(b0,qr[0],negm,0,0,0);p1=__builtin_amdgcn_mfma_f32_32x32x16_bf16(b1,qr[0],negm,0,0,0);}
    else{p0=__builtin_amdgcn_mfma_f32_32x32x16_bf16(b0,qr[d0],p0,0,0,0);p1=__builtin_amdgcn_mfma_f32_32x32x16_bf16(b1,qr[d0],p1,0,0,0);}}
}
typedef __attribute__((address_space(3))) const char* lds_cptr;
typedef short v4i16_t __attribute__((ext_vector_type(4)));
__device__ __forceinline__ void kload8(bf16x8*kf,lds_cptr kp){
  kf[0]=*(const __attribute__((address_space(3))) bf16x8*)(kp);      kf[1]=*(const __attribute__((address_space(3))) bf16x8*)(kp+512);
  kf[2]=*(const __attribute__((address_space(3))) bf16x8*)(kp+2048); kf[3]=*(const __attribute__((address_space(3))) bf16x8*)(kp+2560);
  kf[4]=*(const __attribute__((address_space(3))) bf16x8*)(kp+4096); kf[5]=*(const __attribute__((address_space(3))) bf16x8*)(kp+4608);
  kf[6]=*(const __attribute__((address_space(3))) bf16x8*)(kp+6144); kf[7]=*(const __attribute__((address_space(3))) bf16x8*)(kp+6656);
}
__device__ __forceinline__ void kload2(bf16x8*kf,lds_cptr kp,int j){ kf[2*j]=*(const __attribute__((address_space(3))) bf16x8*)(kp+j*2048); kf[2*j+1]=*(const __attribute__((address_space(3))) bf16x8*)(kp+j*2048+512); }
__device__ __forceinline__ s16x4 vtr(lds_cptr p){ return __builtin_bit_cast(s16x4,__builtin_amdgcn_ds_read_tr16_b64_v4i16((__attribute__((address_space(3))) v4i16_t*)p)); }
__device__ __forceinline__ float rowmax(const f32x16&p0,const f32x16&p1){
  float a=max3f(p0[0],p0[1],p1[0]),b=max3f(p0[2],p0[3],p1[1]);a=max3f(a,p1[2],p1[3]);
  #pragma unroll
  for(int r=4;r<16;r+=4){a=max3f(a,p0[r],p0[r+1]);b=max3f(b,p0[r+2],p0[r+3]);a=max3f(a,p1[r],p1[r+1]);b=max3f(b,p1[r+2],p1[r+3]);}
  const float m=max2f(a,b);
  auto rr=__builtin_amdgcn_permlane32_swap(__float_as_uint(m),__float_as_uint(m),false,false);
  return max2f(__uint_as_float(rr[0]),__uint_as_float(rr[1]));
}
__device__ __forceinline__ void pv(f32x16*o,int vb,bf16x8 pa0,bf16x8 pa1,bf16x8 pa2,bf16x8 pa3){
  #pragma unroll
  for(int d0=0;d0<2;++d0){s16x4 lo[4],hi[4];
    #pragma unroll
    for(int ks=0;ks<4;++ks){
      asm volatile("ds_read_b64_tr_b16 %0,%1 offset:%c2":"=&v"(lo[ks]):"v"(vb),"i"(d0*4096+ks*1024):"memory");
      asm volatile("ds_read_b64_tr_b16 %0,%1 offset:%c2":"=&v"(hi[ks]):"v"(vb),"i"(d0*4096+ks*1024+512):"memory");}
    asm volatile("s_waitcnt lgkmcnt(0)":::"memory");SBAR();
    #define PK(k) (bf16x8){lo[k][0],lo[k][1],lo[k][2],lo[k][3],hi[k][0],hi[k][1],hi[k][2],hi[k][3]}
    o[d0]=__builtin_amdgcn_mfma_f32_32x32x16_bf16(pa0,PK(0),o[d0],0,0,0);
    o[d0]=__builtin_amdgcn_mfma_f32_32x32x16_bf16(pa1,PK(1),o[d0],0,0,0);
    o[d0]=__builtin_amdgcn_mfma_f32_32x32x16_bf16(pa2,PK(2),o[d0],0,0,0);
    o[d0]=__builtin_amdgcn_mfma_f32_32x32x16_bf16(pa3,PK(3),o[d0],0,0,0);
    #undef PK
  }
}

#ifndef ATTN_STORE16
#define ATTN_STORE16(p,v) (*(u32x4*)(p)=(v))
#endif
template<int THRL> __device__ __forceinline__ void attn_unit(const bf16*Qp,const bf16*__restrict__ Kp,const bf16*__restrict__ Vp,bf16*Op,int q0,int t0,const bool SWA,float sink_l2,char*shm,const int tid){
  const int lane=tid&63,r32=lane&31,hi=lane>>5; const int wid=__builtin_amdgcn_readfirstlane(tid>>6);
  const bf16*Qw=Qp+(long)(q0+wid*QBLK)*DM;
  const bf16*Kh=Kp+(long)t0*KVBLK*DM,*Vh=Vp+(long)t0*KVBLK*DM;
  const unsigned lds0=(unsigned)(uintptr_t)shm;
  float*wsf=(float*)(shm+LDS_WS)+wid*64;
  const bf16*ksrc=Kh+(long)lane*DM+wid*8;
  const bf16*vsrc=Vh+(long)(16*(wid&3)+(lane>>2))*DM+(wid>>2)*32+(lane&3)*8;
  const unsigned kdst=lds0+LDS_K+wid*1024, vdst=lds0+LDS_V+wid*1024;
  #define DMA_K(t,slot) glds16(ksrc+(long)(t)*KVBLK*DM,(unsigned)__builtin_amdgcn_readfirstlane(kdst+(slot)))
  #define DMA_V(t,slot) glds16(vsrc+(long)(t)*KVBLK*DM,(unsigned)__builtin_amdgcn_readfirstlane(vdst+(slot)))
  const int vb0=(int)(lds0+LDS_V)+((lane>>4)&1)*32+(lane&3)*8+(4*hi+((lane&15)>>2))*64;
  const char*Kbase=shm+LDS_K; bf16x8 kf[8];
  const lds_cptr shm3=(lds_cptr)shm; const lds_cptr kp0=shm3+LDS_K+hi*1024+r32*16; const lds_cptr vp0=shm3+LDS_V+((lane>>4)&1)*32+(lane&3)*8+(4*hi+((lane&15)>>2))*64;
  const int NT=(q0+QB)/KVBLK-t0;
  DMA_K(0,0);DMA_V(0,0);DMA_K(1,SLOTB);
  bf16x8 qr[4];
  #pragma unroll
  for(int d0=0;d0<4;++d0)qr[d0]=*reinterpret_cast<const bf16x8*>(&Qw[(long)r32*DM+d0*16+hi*8]);
  float mhat=0.f,l_reg=0.f;f32x16 o[2];o[0]=f32x16{};o[1]=f32x16{};f32x16 negm=f32x16{};asm volatile("":"+v"(negm));
  const int qrel=wid*QBLK+r32;
  #define CMASK(P0,P1,t) do{int jb_=(t)-(NT-4); if(SWA)wmask(P0,P1,jb_,qrel,hi); else if(jb_>=0)cmask(P0,P1,jb_,qrel,hi);}while(0)
  bool resc=false;
  #define START(P0,P1) do{ const float rm=rowmax(P0,P1); resc=false; \
    { const float dl=SWA?max2f(rm,sink_l2):rm; mhat=fadd_s(mhat,dl); if(SWA)l_reg=hi?0.f:__builtin_amdgcn_exp2f(sink_l2-dl); \
      _Pragma("unroll") for(int r=0;r<16;++r){P0[r]=fsub_s(P0[r],dl);P1[r]=fsub_s(P1[r],dl);} \
      _Pragma("unroll") for(int r=0;r<16;++r)negm[r]=-mhat; asm volatile("":"+v"(negm)); } \
    _Pragma("unroll") for(int r=0;r<16;++r)P0[r]=__builtin_amdgcn_exp2f(P0[r]); }while(0)
  #define RESC() do{ if(resc){ asm volatile("s_waitcnt lgkmcnt(0)":::"memory"); \
      _Pragma("unroll") for(int d_=0;d_<2;++d_) _Pragma("unroll") for(int r=0;r<16;++r)o[d_][r]*=wsf[crow(r,hi)]; } }while(0)
  f32x16 pA0,pA1,pB0,pB1;
  int sl_prev=0,sl_cur=0,sl_next=SLOTB;
  #define ROT() do{sl_prev=sl_cur;sl_cur=sl_next;sl_next=(sl_next==(NSLOT-1)*SLOTB)?0:sl_next+SLOTB;}while(0)
  DMA_K(2,2*SLOTB);
  WAIT_BAR(3);
  qkt(pA0,pA1,Kbase,qr,negm,r32,hi);asm volatile("s_nop 15\n\ts_nop 7":"+v"(pA0),"+v"(pA1));CMASK(pA0,pA1,0);
  START(pA0,pA1);
  _Pragma("unroll") for(int r=0;r<16;++r)pA1[r]=__builtin_amdgcn_exp2f(pA1[r]);
  WAIT_BAR(0);
  DMA_K(3,0);DMA_V(1,SLOTB);
  ROT();
  kload8(kf,kp0+sl_cur);
  WAIT_BAR(2);
  s16x4 vlo[8],vhi[8]; u32x4 pw0,pw1,pw2,pw3;
  #define PKW(P,B) cvtpk_s(P[B],P[B+1])
  #define PAF(k) __builtin_bit_cast(bf16x8,pw##k)
  #define VFR(i) (bf16x8){vlo[i][0],vlo[i][1],vlo[i][2],vlo[i][3],vhi[i][0],vhi[i][1],vhi[i][2],vhi[i][3]}
  #define PIN(x) asm volatile("":"+v"(x))
  #define MX3(a,b,c) __builtin_fmaxf(__builtin_fmaxf((a),(b)),(c))
  #define GAPA(MF,A0,A1,A2,A3,W0,W1,PW) do{ MF; sacc+=A0; sacc+=A1; sacc+=A2; sacc+=A3; PIN(sacc); W0; W1; PIN(PW); SBAR(); }while(0)
  #define EX(v) __builtin_amdgcn_exp2f(v)
  #define GAPB(MF,X,B) do{ MF; X[B]=EX(X[B]); X[B+1]=EX(X[B+1]); X[B+2]=EX(X[B+2]); X[B+3]=EX(X[B+3]); PIN(X); SBAR(); }while(0)
  #define VRD(i) do{ vlo[i]=vtr(vp_+(((i)>>2)*4096+((i)&3)*1024)); vhi[i]=vtr(vp_+(((i)>>2)*4096+((i)&3)*1024+512)); }while(0)
  #define KRD(G,j) do{ if(G){ kload2(kf,kp0+sl_next,j); SBAR(); } }while(0)
  #define STEP(C0,C1,P0,P1,t,GK,GV,GL) do{ SBAR(); \
    const lds_cptr vp_=vp0+sl_prev; \
    VRD(0); SBAR(); float sacc=(P0[0]+P0[1]); \
    GAPA(C0=__builtin_amdgcn_mfma_f32_32x32x16_bf16(kf[0],qr[0],negm,0,0,0), P0[2],P0[3],P0[4],P0[5],     pw0[0]=PKW(P0,0), pw0[1]=PKW(P0,2), pw0); \
    VRD(4); SBAR(); GAPA(C1=__builtin_amdgcn_mfma_f32_32x32x16_bf16(kf[1],qr[0],negm,0,0,0), P0[6],P0[7],P0[8],P0[9],     pw0[2]=PKW(P0,4), pw0[3]=PKW(P0,6), pw0); \
    VRD(1); SBAR(); GAPA(C0=__builtin_amdgcn_mfma_f32_32x32x16_bf16(kf[2],qr[1],C0,0,0,0),   P0[10],P0[11],P0[12],P0[13], pw1[0]=PKW(P0,8), pw1[1]=PKW(P0,10), pw1); \
    VRD(5); SBAR(); GAPA(C1=__builtin_amdgcn_mfma_f32_32x32x16_bf16(kf[3],qr[1],C1,0,0,0),   P0[14],P0[15],P1[0],P1[1],   pw1[2]=PKW(P0,12),pw1[3]=PKW(P0,14), pw1); \
    VRD(2); SBAR(); GAPA(C0=__builtin_amdgcn_mfma_f32_32x32x16_bf16(kf[4],qr[2],C0,0,0,0),   P1[2],P1[3],P1[4],P1[5],     pw2[0]=PKW(P1,0), pw2[1]=PKW(P1,2), pw2); \
    VRD(6); SBAR(); GAPA(C1=__builtin_amdgcn_mfma_f32_32x32x16_bf16(kf[5],qr[2],C1,0,0,0),   P1[6],P1[7],P1[8],P1[9],     pw2[2]=PKW(P1,4), pw2[3]=PKW(P1,6), pw2); \
    VRD(3); SBAR(); GAPA(C0=__builtin_amdgcn_mfma_f32_32x32x16_bf16(kf[6],qr[3],C0,0,0,0),   P1[10],P1[11],P1[12],P1[13], pw3[0]=PKW(P1,8), pw3[1]=PKW(P1,10), pw3); \
    VRD(7); SBAR(); GAPA(C1=__builtin_amdgcn_mfma_f32_32x32x16_bf16(kf[7],qr[3],C1,0,0,0),   P1[14],P1[15],0.f,0.f,       pw3[2]=PKW(P1,12),pw3[3]=PKW(P1,14), pw3); \
    l_reg+=sacc; \
    if(GK){DMA_K((t)+3,sl_cur);} if(GV){DMA_V((t)+1,sl_next);} \
    CMASK(C0,C1,t); \
    { float a=MX3(C0[0],C0[1],C1[0]),b=MX3(C0[2],C0[3],C1[1]); a=MX3(a,C1[2],C1[3]); \
      _Pragma("unroll") for(int r=4;r<16;r+=4){a=MX3(a,C0[r],C0[r+1]);b=MX3(b,C0[r+2],C0[r+3]);a=MX3(a,C1[r],C1[r+1]);b=MX3(b,C1[r+2],C1[r+3]);} \
      float rm=__builtin_fmaxf(a,b); { auto rr=__builtin_amdgcn_permlane32_swap(__float_as_uint(rm),__float_as_uint(rm),false,false); rm=__builtin_fmaxf(__uint_as_float(rr[0]),__uint_as_float(rr[1])); } \
      resc=false; \
      if(__builtin_expect(__any(rm>(float)THRL),0)){ const float dl=__builtin_fmaxf(rm,0.f); mhat+=dl; \
        _Pragma("unroll") for(int r=0;r<16;++r){C0[r]-=dl;C1[r]-=dl;} \
        _Pragma("unroll") for(int r=0;r<16;++r)negm[r]=-mhat; asm volatile("":"+v"(negm)); \
        const float f=__builtin_amdgcn_exp2f(-dl); l_reg*=f; if(hi==0)wsf[r32]=f; resc=true; } } \
    SBAR(); \
    GAPB(o[0]=__builtin_amdgcn_mfma_f32_32x32x16_bf16(PAF(0),VFR(0),o[0],0,0,0), C0,0); \
    GAPB(o[1]=__builtin_amdgcn_mfma_f32_32x32x16_bf16(PAF(0),VFR(4),o[1],0,0,0), C0,4); \
    KRD(GL,0); GAPB(o[0]=__builtin_amdgcn_mfma_f32_32x32x16_bf16(PAF(1),VFR(1),o[0],0,0,0), C0,8); \
    KRD(GL,1); GAPB(o[1]=__builtin_amdgcn_mfma_f32_32x32x16_bf16(PAF(1),VFR(5),o[1],0,0,0), C0,12); \
    KRD(GL,2); GAPB(o[0]=__builtin_amdgcn_mfma_f32_32x32x16_bf16(PAF(2),VFR(2),o[0],0,0,0), C1,0); \
    KRD(GL,3); GAPB(o[1]=__builtin_amdgcn_mfma_f32_32x32x16_bf16(PAF(2),VFR(6),o[1],0,0,0), C1,4); \
    GAPB(o[0]=__builtin_amdgcn_mfma_f32_32x32x16_bf16(PAF(3),VFR(3),o[0],0,0,0), C1,8); \
    GAPB(o[1]=__builtin_amdgcn_mfma_f32_32x32x16_bf16(PAF(3),VFR(7),o[1],0,0,0), C1,12); \
    }while(0)
  int t=1;
  #undef CMASK
  #define CMASK(P0,P1,t) do{}while(0)
  for(;t+5<NT;t+=2){
    STEP(pB0,pB1,pA0,pA1,t,true,true,true);     WAIT_BAR(2); RESC(); ROT();
    STEP(pA0,pA1,pB0,pB1,t+1,true,true,true);   WAIT_BAR(2); RESC(); ROT();
  }
  #undef CMASK
  #define CMASK(P0,P1,t) do{int jb_=(t)-(NT-4); if(SWA)wmask(P0,P1,jb_,qrel,hi); else if(jb_>=0)cmask(P0,P1,jb_,qrel,hi);}while(0)
  #define ENDW(tt) do{ if((tt)+3<NT){WAIT_BAR(2);} else if((tt)+2<NT){WAIT_BAR(1);} else {WAIT_BAR(0);} }while(0)
  for(;t+1<NT;t+=2){
    STEP(pB0,pB1,pA0,pA1,t,(t+3<NT),(t+1<NT),(t+1<NT));       ENDW(t);   RESC(); ROT();
    STEP(pA0,pA1,pB0,pB1,t+1,(t+4<NT),(t+2<NT),(t+2<NT));     ENDW(t+1); RESC(); ROT();
  }
  STEP(pB0,pB1,pA0,pA1,NT-1,false,false,false); RESC();
  { float sacc=pB0[0]+pB0[1]; _Pragma("unroll") for(int r=2;r<16;++r)sacc+=pB0[r]; _Pragma("unroll") for(int r=0;r<16;++r)sacc+=pB1[r]; l_reg+=sacc;
    pw0=(u32x4){PKW(pB0,0),PKW(pB0,2),PKW(pB0,4),PKW(pB0,6)};pw1=(u32x4){PKW(pB0,8),PKW(pB0,10),PKW(pB0,12),PKW(pB0,14)};pw2=(u32x4){PKW(pB1,0),PKW(pB1,2),PKW(pB1,4),PKW(pB1,6)};pw3=(u32x4){PKW(pB1,8),PKW(pB1,10),PKW(pB1,12),PKW(pB1,14)};
    SBAR(); pv(o,vb0+sl_cur,PAF(0),PAF(1),PAF(2),PAF(3)); }
  #undef PKW
  #undef PAF
  #undef VFR
  #undef PIN
  #undef MX3
  #undef GAPA
  #undef GAPB
  #undef EX
  #undef VRD
  #undef KRD
  #undef STEP
  #undef ENDW
  {auto rr=__builtin_amdgcn_permlane32_swap(__float_as_uint(l_reg),__float_as_uint(l_reg),false,false);l_reg=__uint_as_float(rr[0])+__uint_as_float(rr[1]);}
  if(hi==0)wsf[32+r32]=l_reg;asm volatile("s_waitcnt lgkmcnt(0)":::"memory");
  float rli[16];
  #pragma unroll
  for(int r=0;r<16;++r)rli[r]=__builtin_amdgcn_rcpf(wsf[32+crow(r,hi)]);
  bf16*Ow=Op+(long)(q0+wid*QBLK)*PO;
  { bf16*stg=(bf16*)(shm+LDS_OST)+wid*2048;
    #pragma unroll
    for(int r=0;r<16;++r){const int orow=crow(r,hi);
      #pragma unroll
      for(int d0=0;d0<2;++d0)stg[orow*64+d0*32+r32]=__float2bfloat16(o[d0][r]*rli[r]);}
    asm volatile("s_waitcnt lgkmcnt(0)":::"memory");
    #pragma unroll
    for(int i=0;i<4;++i){const int row=i*8+(lane>>3),ch=lane&7; const u32x4 v=*(const u32x4*)(stg+row*64+ch*8); ATTN_STORE16(Ow+(long)row*PO+ch*8,v);} }
  asm volatile("s_waitcnt lgkmcnt(0)\n\ts_barrier":::"memory");
  #undef DMA_K
  #undef DMA_V
  #undef CMASK
  #undef START
  #undef RESC
  #undef ROT
}
constexpr int ATTN_LDS_BYTES=LDS_BYTES;
#undef SBAR
#undef WAIT_BAR
}
constexpr int NWAVES = 8;
constexpr int TOK = 16384, SEQL = 4096, DMODEL = 2048, EVEN_IN = 4352, ODD_IN = 4096, DFF = 8192;
constexpr float EPSN = 1e-6f;
constexpr float LOG2E = 1.4426950408889634f;
constexpr size_t MiB = 1u << 20;
constexpr size_t WS_WIN = 1 * MiB, WS_WOUT = 18 * MiB, WS_W1 = 26 * MiB, WS_W2 = 58 * MiB, WS_WG = 90 * MiB;
constexpr size_t WS_H = 92 * MiB;
constexpr size_t WS_RS = 128 * 1024;
constexpr size_t WS_XBUF = 220 * MiB;
constexpr int CW_X = 8192;
constexpr size_t WS_MIX = 156 * MiB;
constexpr size_t WS_CARRY = 156 * MiB;
constexpr size_t WS_R = 224 * MiB;
constexpr size_t WS_PROJ = WS_R;
constexpr size_t WS_ATT = WS_R + 136 * MiB;
constexpr size_t WS_MIXIN = WS_R + 200 * MiB;
constexpr size_t WS_Z = WS_R;
constexpr size_t WS_GATES = WS_R + 128 * MiB;
constexpr size_t WS_END = WS_R + 264 * MiB;
constexpr int LDS_BYTES = 147456;
constexpr int N_PHASES = 19;
constexpr int LDSCTL_OFF = 144384, MISC_OFF = LDSCTL_OFF + 320;

typedef unsigned short bf16;
typedef unsigned v4u __attribute__((ext_vector_type(4)));
typedef unsigned v2u __attribute__((ext_vector_type(2)));
typedef float f32x4 __attribute__((ext_vector_type(4)));
#define LAS __attribute__((address_space(3)))
#define LDS_WAIT() asm volatile("s_waitcnt lgkmcnt(0)" ::: "memory")
__device__ __forceinline__ unsigned f2bf(float f) { unsigned u = __builtin_bit_cast(unsigned, f); return (u + 0x7fffu + ((u >> 16) & 1u)) >> 16; }
__device__ __forceinline__ unsigned pk2(float lo, float hi) { return f2bf(lo) | (f2bf(hi) << 16); }
__device__ __forceinline__ float bflo(unsigned w) { return __builtin_bit_cast(float, w << 16); }
__device__ __forceinline__ float bfhi(unsigned w) { return __builtin_bit_cast(float, w & 0xffff0000u); }
#define UNPK8(dst, v) do { dst[0] = bflo((v).x); dst[1] = bfhi((v).x); dst[2] = bflo((v).y); dst[3] = bfhi((v).y); dst[4] = bflo((v).z); dst[5] = bfhi((v).z); dst[6] = bflo((v).w); dst[7] = bfhi((v).w); } while (0)
__device__ __forceinline__ float wave_sum(float v) {
#pragma unroll
    for (int o = 1; o < 64; o <<= 1) v += __shfl_xor(v, o);
    return v;
}
__device__ __forceinline__ int lane_id_v() { int l; asm volatile("v_mbcnt_lo_u32_b32 %0, -1, 0\n\tv_mbcnt_hi_u32_b32 %0, -1, %0" : "=v"(l)); return l; }
__device__ __forceinline__ float sigmoidf_(float x) { return __builtin_amdgcn_rcpf(1.f + __builtin_amdgcn_exp2f(-LOG2E * x)); }

constexpr int TR_LD = 65, TR_WAVE_BYTES = 64 * TR_LD * 4;
__device__ __forceinline__ void transpose_item(const float* W, int K, int N, bf16* WT, int row_off, LAS float* scr, int item, int lane, const float* gk = nullptr) {
    const int nblk = N / 64, kb = item / nblk, nb = item % nblk, k0 = 64 * kb, n0 = 64 * nb;
    const int n4 = (lane & 15) * 4, kr = lane >> 4;
    f32x4 v[16];
#pragma unroll
    for (int i = 0; i < 16; ++i) v[i] = __builtin_nontemporal_load((const f32x4*)(W + (size_t)(k0 + 4 * i + kr) * N + n0 + n4));
#pragma unroll
    for (int i = 0; i < 16; ++i) { LAS float* d = scr + (4 * i + kr) * TR_LD + n4; const float gs = gk ? gk[k0 + 4 * i + kr] : 1.0f; d[0] = v[i].x * gs; d[1] = v[i].y * gs; d[2] = v[i].z * gs; d[3] = v[i].w * gs; }
    LDS_WAIT(); asm volatile("" ::: "memory");
    const int c = lane & 7;
#pragma unroll
    for (int j = 0; j < 8; ++j) { const int n = (lane >> 3) + 8 * j; const LAS float* s = scr + (8 * c) * TR_LD + n;
        v4u o; o.x = pk2(s[0 * TR_LD], s[1 * TR_LD]); o.y = pk2(s[2 * TR_LD], s[3 * TR_LD]); o.z = pk2(s[4 * TR_LD], s[5 * TR_LD]); o.w = pk2(s[6 * TR_LD], s[7 * TR_LD]);
        *(v4u*)(WT + (size_t)(row_off + n0 + n) * K + k0 + 8 * c) = o; }
    LDS_WAIT(); asm volatile("" ::: "memory");
}

struct Params { const float* in[22]; float* out; unsigned char* ws; int lo, hi; };
typedef const __attribute__((address_space(4))) Params CParams;
__device__ __forceinline__ CParams* kargs() { CParams* kp = (CParams*)__builtin_amdgcn_kernarg_segment_ptr(); asm volatile("" : "+s"(kp)); return kp; }

__device__ __forceinline__ void convert_weights(CParams& p, int layer, int which  , LAS float* scr, int gw, int NGW, int lane) {
    unsigned char* ws = p.ws;
    const int I_IN = (layer == 0) ? 32 * (EVEN_IN / 64) : 32 * (ODD_IN / 64), I_OUT = 32 * 32, I_1 = 32 * 128, I_2 = 128 * 32, I_G = (layer == 0) ? 0 : 16 * 16;
    const int NIT = I_IN + I_OUT + I_1 + I_2 + I_G;
    const int it_lo = (which & 2) ? 0 : I_1, it_hi = (which & 1) ? NIT : I_1;
    const float* win = (layer == 0) ? p.in[1] : p.in[9]; const int nin = (layer == 0) ? EVEN_IN : ODD_IN;
    const float* wout = (layer == 0) ? p.in[8] : p.in[15];
    const float* w1 = p.in[20] + (size_t)layer * DMODEL * DFF; const float* w2 = p.in[21] + (size_t)layer * DFF * DMODEL;
    for (int it = it_lo + gw; it < it_hi; it += NGW) {
        int r = it;
        if (r < I_1) { transpose_item(w1, DMODEL, DFF, (bf16*)(ws + WS_W1), 0, scr, r, lane, p.in[18] + layer * DMODEL); continue; } r -= I_1;
        if (r < I_OUT) { transpose_item(wout, DMODEL, DMODEL, (bf16*)(ws + WS_WOUT), 0, scr, r, lane); continue; } r -= I_OUT;
        if (r < I_2) { transpose_item(w2, DFF, DMODEL, (bf16*)(ws + WS_W2), 0, scr, r, lane); continue; } r -= I_2;
        if (r < I_IN) { transpose_item(win, DMODEL, nin, (bf16*)(ws + WS_WIN), 0, scr, r, lane, p.in[16] + layer * DMODEL); continue; } r -= I_IN;
        { const int gn = r >> 4, g = gn >> 3, n = gn & 7;
          transpose_item(p.in[12] + (size_t)gn * 65536, 256, 256, (bf16*)(ws + WS_WG), n * 512 + g * 256, scr, r & 15, lane); }
    }
}

__device__ __forceinline__ void row_phase(const float* xin, const bf16* xb_in, const bf16* y, const float* gpost, bf16* xb_out, float* rs, float* out_f32, int gw, int NGW, int lane) {
    for (int m = gw; m < TOK; m += NGW) {
        f32x4 v[8];
        if (xin) { const f32x4* xr = (const f32x4*)(xin + (size_t)m * DMODEL) + lane;
#pragma unroll
            for (int j = 0; j < 8; ++j) v[j] = __builtin_nontemporal_load(xr + 64 * j); }
        else { const v2u* xr = (const v2u*)(xb_in + (size_t)m * DMODEL) + lane;
#pragma unroll
            for (int j = 0; j < 8; ++j) { const v2u w = xr[64 * j]; v[j] = (f32x4){bflo(w.x), bfhi(w.x), bflo(w.y), bfhi(w.y)}; } }
        if (y) {
            const v2u* yr = (const v2u*)(y + (size_t)m * DMODEL) + lane; v2u yy[8]; float ss = 0.f;
#pragma unroll
            for (int j = 0; j < 8; ++j) { yy[j] = yr[64 * j]; const float a = bflo(yy[j].x), b = bfhi(yy[j].x), c = bflo(yy[j].y), d = bfhi(yy[j].y); ss += (a * a + b * b) + (c * c + d * d); }
            const float r = 1.0f / sqrtf(wave_sum(ss) * (1.f / DMODEL) + EPSN);
#pragma unroll
            for (int j = 0; j < 8; ++j) { const f32x4 g = ((const f32x4*)gpost)[64 * j + lane];
                v[j].x += bflo(yy[j].x) * r * g.x; v[j].y += bfhi(yy[j].x) * r * g.y; v[j].z += bflo(yy[j].y) * r * g.z; v[j].w += bfhi(yy[j].y) * r * g.w; }
        }
        if (out_f32) { f32x4* xo = (f32x4*)(out_f32 + (size_t)m * DMODEL) + lane;
#pragma unroll
            for (int j = 0; j < 8; ++j) __builtin_nontemporal_store(v[j], xo + 64 * j); }
        if (xb_out) {
            float ss = 0.f;
#pragma unroll
            for (int j = 0; j < 8; ++j) ss += (v[j].x * v[j].x + v[j].y * v[j].y) + (v[j].z * v[j].z + v[j].w * v[j].w);
            const float tot = wave_sum(ss);
            if (lane == 0) rs[m] = tot;
            v2u* ho = (v2u*)(xb_out + (size_t)m * DMODEL) + lane;
#pragma unroll
            for (int j = 0; j < 8; ++j) { v2u o; o.x = pk2(v[j].x, v[j].y); o.y = pk2(v[j].z, v[j].w); ho[64 * j] = o; }
        }
    }
}

__device__ __forceinline__ void diff_combine(CParams& p, int gw, int NGW, int lane) {
    const bf16* att = (const bf16*)(p.ws + WS_ATT); bf16* mixin = (bf16*)(p.ws + WS_MIXIN);
    const float s1 = wave_sum(p.in[2][lane] * p.in[3][lane]), s2 = wave_sum(p.in[4][lane] * p.in[5][lane]);
    const float lambda_init = 0.2f;
    const float lam = expf(s1) - expf(s2) + lambda_init;
    const int l16 = lane & 15, hsub = lane >> 4;
    float g[8];
#pragma unroll
    for (int k = 0; k < 8; ++k) g[k] = p.in[6][l16 * 8 + k] * (1.0f - lambda_init);
    for (int it0 = gw; it0 < TOK * 2; it0 += 4 * NGW) {
      v4u av[4], bv[4];
#pragma unroll
      for (int q = 0; q < 4; ++q) { const int it = (it0 + q * NGW < TOK * 2) ? it0 + q * NGW : it0; const int t = it >> 1, h = (it & 1) * 4 + hsub;
        av[q] = *(const v4u*)(att + (size_t)t * 2048 + 256 * h + l16 * 8); bv[q] = *(const v4u*)(att + (size_t)t * 2048 + 256 * h + 128 + l16 * 8); }
#pragma unroll
      for (int q = 0; q < 4; ++q) { const int it = it0 + q * NGW; if (it >= TOK * 2) break;
        const int t = it >> 1, h = (it & 1) * 4 + hsub;
        const v4u a = av[q], b = bv[q];
        float v[8];
        v[0] = bflo(a.x) - lam * bflo(b.x); v[1] = bfhi(a.x) - lam * bfhi(b.x); v[2] = bflo(a.y) - lam * bflo(b.y); v[3] = bfhi(a.y) - lam * bfhi(b.y);
        v[4] = bflo(a.z) - lam * bflo(b.z); v[5] = bfhi(a.z) - lam * bfhi(b.z); v[6] = bflo(a.w) - lam * bflo(b.w); v[7] = bfhi(a.w) - lam * bfhi(b.w);
        float ss = 0.f;
#pragma unroll
        for (int k = 0; k < 8; ++k) ss += v[k] * v[k];
        ss += __shfl_xor(ss, 1); ss += __shfl_xor(ss, 2); ss += __shfl_xor(ss, 4); ss += __shfl_xor(ss, 8);
        const float r = 1.0f / sqrtf(ss * (1.f / 128.f) + EPSN);
        v4u o; o.x = pk2(v[0] * r * g[0], v[1] * r * g[1]); o.y = pk2(v[2] * r * g[2], v[3] * r * g[3]); o.z = pk2(v[4] * r * g[4], v[5] * r * g[5]); o.w = pk2(v[6] * r * g[6], v[7] * r * g[7]);
        *(v4u*)(mixin + (size_t)t * 2048 + 128 * h + l16 * 8) = o;
      }
    }
}

__device__ __forceinline__ void conv_phase(CParams& p, int gtid, int NT) {
    const bf16* proj = (const bf16*)(p.ws + WS_PROJ); bf16* xc = (bf16*)p.out;
    const float* cw = p.in[10]; const float* cb = p.in[11];
    constexpr int RUN = 32;
    for (int idx = gtid; idx < (TOK / RUN) * 256; idx += NT) {
        const int ch = (idx & 255) * 8, t0 = (idx >> 8) * RUN;
        float w[4][8], bs[8];
#pragma unroll
        for (int j = 0; j < 4; ++j) { const f32x4 a = *(const f32x4*)(cw + j * 2048 + ch), b = *(const f32x4*)(cw + j * 2048 + ch + 4); w[j][0] = a.x; w[j][1] = a.y; w[j][2] = a.z; w[j][3] = a.w; w[j][4] = b.x; w[j][5] = b.y; w[j][6] = b.z; w[j][7] = b.w; }
        { const f32x4 a = *(const f32x4*)(cb + ch), b = *(const f32x4*)(cb + ch + 4); bs[0] = a.x; bs[1] = a.y; bs[2] = a.z; bs[3] = a.w; bs[4] = b.x; bs[5] = b.y; bs[6] = b.z; bs[7] = b.w; }
        const bf16* src = proj + (size_t)t0 * ODD_IN + 2048 + ch; bf16* dst = xc + (size_t)t0 * 2048 + ch;
        v4u x0 = (v4u){0u, 0u, 0u, 0u}, x1 = x0, x2 = x0;
        if ((t0 & (SEQL - 1)) != 0) { x0 = *(const v4u*)(src - 3 * ODD_IN); x1 = *(const v4u*)(src - 2 * ODD_IN); x2 = *(const v4u*)(src - 1 * ODD_IN); }
        for (int sb = 0; sb < RUN; sb += 8) {
          v4u xin[8];
#pragma unroll
          for (int i = 0; i < 8; ++i) xin[i] = *(const v4u*)(src + (size_t)(sb + i) * ODD_IN);
#pragma unroll
          for (int i = 0; i < 8; ++i) { const int s = sb + i;
            const v4u x3 = xin[i];
            float acc[8];
#pragma unroll
            for (int k = 0; k < 8; ++k) {
                const unsigned a0 = (k < 2) ? x0.x : (k < 4) ? x0.y : (k < 6) ? x0.z : x0.w, a1 = (k < 2) ? x1.x : (k < 4) ? x1.y : (k < 6) ? x1.z : x1.w;
                const unsigned a2 = (k < 2) ? x2.x : (k < 4) ? x2.y : (k < 6) ? x2.z : x2.w, a3 = (k < 2) ? x3.x : (k < 4) ? x3.y : (k < 6) ? x3.z : x3.w;
                const float f0 = (k & 1) ? bfhi(a0) : bflo(a0), f1 = (k & 1) ? bfhi(a1) : bflo(a1), f2 = (k & 1) ? bfhi(a2) : bflo(a2), f3 = (k & 1) ? bfhi(a3) : bflo(a3);
                acc[k] = bs[k] + w[0][k] * f0 + w[1][k] * f1 + w[2][k] * f2 + w[3][k] * f3;
            }
            v4u o; o.x = pk2(acc[0], acc[1]); o.y = pk2(acc[2], acc[3]); o.z = pk2(acc[4], acc[5]); o.w = pk2(acc[6], acc[7]);
            *(v4u*)(dst + (size_t)s * 2048) = o;
            x0 = x1; x1 = x2; x2 = x3;
          }
        }
    }
}

constexpr int SCH = 128, SLEN = SEQL / SCH;
template <int PASS> __device__ __forceinline__ void scan_phase(CParams& p, LAS unsigned char* ldsb, int wave, int lane) {
    const bf16* gates = (const bf16*)(p.ws + WS_GATES); bf16* xc = (bf16*)p.out; const bf16* proj = (const bf16*)(p.ws + WS_PROJ);
    float* cA = (float*)(p.ws + WS_CARRY); float* cH = cA + 4 * SCH * 2048;
    float* sA = cH + 4 * SCH * 2048; float* sH = sA + 4 * (SCH / 8) * 2048;
    for (int wgi = blockIdx.x; wgi < 4 * (SCH / 8) * 4; wgi += gridDim.x) {
        const int grp = wgi & 3, sc = (wgi >> 2) & (SCH / 8 - 1), b = wgi / (4 * (SCH / 8)), c = sc * 8 + wave;
        const int ch = grp * 512 + lane * 8, n = ch >> 8, e = ch & 255;
        float sp8[8], b0[8], b1[8];
#pragma unroll
        for (int q = 0; q < 2; ++q) { const f32x4 lm = *(const f32x4*)(p.in[14] + ch + 4 * q), g0 = *(const f32x4*)(p.in[13] + ch + 4 * q), g1 = *(const f32x4*)(p.in[13] + 2048 + ch + 4 * q);
#pragma unroll
          for (int k = 0; k < 4; ++k) { sp8[4 * q + k] = -8.0f * LOG2E * log1pf(expf(-lm[k])); b0[4 * q + k] = g0[k]; b1[4 * q + k] = g1[k]; } }
        float h[8], ap[8];
#pragma unroll
        for (int k = 0; k < 8; ++k) { h[k] = 0.f; ap[k] = 1.f; }
        if (PASS == 2) {
#pragma unroll 8
            for (int j = 0; j < sc; ++j) { const float* pa = sA + (size_t)(b * (SCH / 8) + j) * 2048 + ch; const float* ph_ = sH + (size_t)(b * (SCH / 8) + j) * 2048 + ch;
                const f32x4 a0 = *(const f32x4*)pa, a1 = *(const f32x4*)(pa + 4), h0 = *(const f32x4*)ph_, h1 = *(const f32x4*)(ph_ + 4);
#pragma unroll
                for (int k = 0; k < 4; ++k) { h[k] = a0[k] * h[k] + h0[k]; h[4 + k] = a1[k] * h[4 + k] + h1[k]; } }
#pragma unroll 8
            for (int j = sc * 8; j < c; ++j) { const float* pa = cA + (size_t)(b * SCH + j) * 2048 + ch; const float* ph_ = cH + (size_t)(b * SCH + j) * 2048 + ch;
                const f32x4 a0 = *(const f32x4*)pa, a1 = *(const f32x4*)(pa + 4), h0 = *(const f32x4*)ph_, h1 = *(const f32x4*)(ph_ + 4);
#pragma unroll
                for (int k = 0; k < 4; ++k) { h[k] = a0[k] * h[k] + h0[k]; h[4 + k] = a1[k] * h[4 + k] + h1[k]; } }
        }
        const size_t t0 = (size_t)b * SEQL + (size_t)c * SLEN;
        const bf16* gp = gates + t0 * 4096 + n * 512 + e; bf16* xp = xc + t0 * 2048 + ch; const bf16* yp = proj + t0 * ODD_IN + ch;
#define SCAN_STEP(G0v, G1v, XVv) do { float gg0[8], gg1[8], xx[8]; UNPK8(gg0, G0v); UNPK8(gg1, G1v); UNPK8(xx, XVv); \
            _Pragma("unroll") for (int k = 0; k < 8; ++k) { \
                const float r = sigmoidf_(gg0[k] + b0[k]), ig = sigmoidf_(gg1[k] + b1[k]); \
                const float a = __builtin_amdgcn_exp2f(r * sp8[k]);                    \
                const float u = sqrtf(fmaxf(1.0f - a * a, 0.f)) * (ig * xx[k]); \
                h[k] = a * h[k] + u; ap[k] *= a; } } while (0)
        if (PASS == 1) {
            constexpr int BS = 4;
            v4u gA0[BS], gA1[BS], xA[BS], gB0[BS], gB1[BS], xB[BS];
#define SCAN_LOAD1(g0_, g1_, x_, s0_) do { _Pragma("unroll") for (int i = 0; i < BS; ++i) { const size_t s_ = (size_t)((s0_) + i); \
                g0_[i] = *(const v4u*)(gp + s_ * 4096); g1_[i] = *(const v4u*)(gp + s_ * 4096 + 256); x_[i] = *(const v4u*)(xp + s_ * 2048); } } while (0)
#define SCAN_RUN1(g0_, g1_, x_) do { _Pragma("unroll") for (int i = 0; i < BS; ++i) { SCAN_STEP(g0_[i], g1_[i], x_[i]); } } while (0)
            SCAN_LOAD1(gA0, gA1, xA, 0);
#pragma unroll 1
            for (int s0 = 0; s0 < SLEN; s0 += 2 * BS) {
                SCAN_LOAD1(gB0, gB1, xB, s0 + BS);
                SCAN_RUN1(gA0, gA1, xA);
                if (s0 + 2 * BS < SLEN) SCAN_LOAD1(gA0, gA1, xA, s0 + 2 * BS);
                SCAN_RUN1(gB0, gB1, xB);
            }
#undef SCAN_LOAD1
#undef SCAN_RUN1
        } else {
            constexpr int BS = 4;
            v4u gA0[BS], gA1[BS], xA[BS], yA[BS], gB0[BS], gB1[BS], xB[BS], yB[BS];
#define SCAN_LOAD(g0_, g1_, x_, y_, s0_) do { _Pragma("unroll") for (int i = 0; i < BS; ++i) { const size_t s_ = (size_t)((s0_) + i); \
                g0_[i] = *(const v4u*)(gp + s_ * 4096); g1_[i] = *(const v4u*)(gp + s_ * 4096 + 256); x_[i] = *(const v4u*)(xp + s_ * 2048); y_[i] = *(const v4u*)(yp + s_ * ODD_IN); } } while (0)
#define SCAN_RUN(g0_, g1_, x_, y_, s0_) do { _Pragma("unroll") for (int i = 0; i < BS; ++i) { SCAN_STEP(g0_[i], g1_[i], x_[i]); \
                float yy[8]; UNPK8(yy, y_[i]); v4u ov; ov.x = pk2(h[0] * yy[0], h[1] * yy[1]); ov.y = pk2(h[2] * yy[2], h[3] * yy[3]); ov.z = pk2(h[4] * yy[4], h[5] * yy[5]); ov.w = pk2(h[6] * yy[6], h[7] * yy[7]); \
                *(v4u*)(xp + (size_t)((s0_) + i) * 2048) = ov; } } while (0)
            SCAN_LOAD(gA0, gA1, xA, yA, 0);
#pragma unroll
            for (int s0 = 0; s0 < SLEN; s0 += 2 * BS) {
                SCAN_LOAD(gB0, gB1, xB, yB, s0 + BS);
                SCAN_RUN(gA0, gA1, xA, yA, s0);
                if (s0 + 2 * BS < SLEN) SCAN_LOAD(gA0, gA1, xA, yA, s0 + 2 * BS);
                SCAN_RUN(gB0, gB1, xB, yB, s0 + BS);
            }
#undef SCAN_LOAD
#undef SCAN_RUN
        }
#undef SCAN_STEP
        if (PASS == 1) { float* pa = cA + (size_t)(b * SCH + c) * 2048 + ch; float* ph_ = cH + (size_t)(b * SCH + c) * 2048 + ch;
            *(f32x4*)pa = (f32x4){ap[0], ap[1], ap[2], ap[3]}; *(f32x4*)(pa + 4) = (f32x4){ap[4], ap[5], ap[6], ap[7]};
            *(f32x4*)ph_ = (f32x4){h[0], h[1], h[2], h[3]}; *(f32x4*)(ph_ + 4) = (f32x4){h[4], h[5], h[6], h[7]}; }
        if (PASS == 1) {
            LAS float* L = (LAS float*)ldsb + (wave * 512 + lane * 8) * 2;
#pragma unroll
            for (int k = 0; k < 8; ++k) { L[2 * k] = ap[k]; L[2 * k + 1] = h[k]; }
            __syncthreads();
            if (wave == 0) { float ca[8], chh[8];
#pragma unroll
                for (int k = 0; k < 8; ++k) { ca[k] = 1.f; chh[k] = 0.f; }
                for (int w = 0; w < 8; ++w) { const LAS float* Lw = (const LAS float*)ldsb + (w * 512 + lane * 8) * 2;
#pragma unroll
                    for (int k = 0; k < 8; ++k) { const float a = Lw[2 * k], hh = Lw[2 * k + 1]; chh[k] = a * chh[k] + hh; ca[k] *= a; } }
                float* pa = sA + (size_t)(b * (SCH / 8) + sc) * 2048 + ch; float* ph_ = sH + (size_t)(b * (SCH / 8) + sc) * 2048 + ch;
                *(f32x4*)pa = (f32x4){ca[0], ca[1], ca[2], ca[3]}; *(f32x4*)(pa + 4) = (f32x4){ca[4], ca[5], ca[6], ca[7]};
                *(f32x4*)ph_ = (f32x4){chh[0], chh[1], chh[2], chh[3]}; *(f32x4*)(ph_ + 4) = (f32x4){chh[4], chh[5], chh[6], chh[7]}; }
            __syncthreads();
        }
    }
}

__device__ __forceinline__ void attention_phase(CParams& p, char* lds, const int tid) {
    using abf = attn_body::bf16;
    const abf* proj = (const abf*)(p.ws + WS_PROJ); abf* att = (abf*)(p.ws + WS_ATT); abf* mixin = (abf*)(p.ws + WS_MIXIN);
    const int G = gridDim.x, c = blockIdx.x, nd = (2048 + G - 1) / G, ns = (1024 + G - 1) / G;
    for (int i = 0; i < nd + ns; ++i) {
        const abf *Qp, *Kp, *Vp; abf* Op; int q0, t0; bool swa; float sink_l2 = 0.f;
        if (i < nd) {
            const int pos = (i & 1) ? G - 1 - c : c, L = i * G + pos;
            if (L >= 2048) continue;
            int qb = 15 - (L >> 7), combo = L & 127, b = combo >> 5, ic = combo & 31, hq = ic >> 1, cc = ic & 1;
            if (G == 256) {
                const int xcd = pos & 7, slot = pos >> 3, member = slot & 3, cl = (slot >> 2) & 3, half = slot >> 4, cluster = xcd * 4 + cl;
                b = cluster >> 3; hq = 2 * (cluster & 7) + (member >> 1); cc = member & 1; ic = 2 * hq + cc; qb = 15 - (2 * i + half);
            }
            const abf* base = proj + (size_t)b * SEQL * EVEN_IN;
            Qp = base + hq * 64; Kp = base + 1024 + hq * 64; Vp = base + 2048 + (hq >> 1) * 128 + cc * 64; Op = att + (size_t)b * SEQL * 2048 + ic * 64; q0 = qb * 256; t0 = 0; swa = false;
        } else {
            const int L = (i - nd) * G + c; if (L >= 1024) continue;
            const int b = L >> 8, hq = (L >> 4) & 15, qb = L & 15;
            const abf* base = proj + (size_t)b * SEQL * EVEN_IN;
            sink_l2 = p.in[7][hq] * LOG2E;
            Qp = base + 3072 + hq * 64; Kp = base + 4096 + (hq >> 3) * 64; Vp = base + 4224 + (hq >> 3) * 64; Op = mixin + (size_t)b * SEQL * 2048 + 1024 + hq * 64; q0 = qb * 256; t0 = qb ? qb * 4 - 2 : 0; swa = true;
        }
        attn_body::attn_unit<8>(Qp, Kp, Vp, Op, q0, t0, swa, sink_l2, lds, tid);
    }
}

#define RLX_AGENT __ATOMIC_RELAXED, __HIP_MEMORY_SCOPE_AGENT
constexpr int CW_BAR = 4096;
constexpr size_t CTL_ZERO_BYTES = 65536;
#define XB_TMO      128
#define XB_XCNT(j)  (256  + 64 * (j))
#define XB_XSUB(j)  (1280 + 64 * (j))
#define XB_XGEN(j)  (2304 + 64 * (j))
#define XB_TOP      3328
#define XB_TOPGEN   3392
#define XCD_BAR_WORDS 3456
#define XB_SPIN_CAP (1u << 18)

__device__ __forceinline__ unsigned xb_ld(unsigned* p)              { return __hip_atomic_load(p, __ATOMIC_RELAXED, __HIP_MEMORY_SCOPE_AGENT); }
__device__ __forceinline__ unsigned xb_add(unsigned* p, unsigned v) { return __hip_atomic_fetch_add(p, v, __ATOMIC_RELAXED, __HIP_MEMORY_SCOPE_AGENT); }
__device__ __forceinline__ unsigned xb_xcc_id() { return (unsigned)__builtin_amdgcn_s_getreg((3 << 11) | 20) & 0xFu; }
#define XB_SPIN(cond, bar) do { unsigned _sp = 0; while (cond) { __builtin_amdgcn_s_sleep(1); \
    if ((++_sp & 255u) == 0u) { if (xb_ld(&(bar)[XB_TMO])) break; if (_sp > XB_SPIN_CAP) { atomicAdd(&(bar)[XB_TMO], 1u); break; } } } } while (0)

struct XcdBarrier {
    unsigned* bar; unsigned x;
    volatile LAS unsigned* st;
};

__device__ __forceinline__ XcdBarrier xcd_barrier_post(unsigned* bar, volatile LAS unsigned* st) {
    XcdBarrier b; b.bar = bar; b.x = xb_xcc_id(); b.st = st;
    if (threadIdx.x == 0) (void)xb_add(&bar[XB_XCNT(b.x)], 1u);
    return b;
}
__device__ __forceinline__ void xcd_barrier_complete(unsigned* bar, unsigned x, unsigned& nloc, unsigned& nx) {
    const unsigned G = gridDim.x * gridDim.y * gridDim.z;
    unsigned sum, cnt, mine, sp = 0u;
    for (;;) {
        sum = 0u; cnt = 0u; mine = 0u;
#pragma unroll
        for (unsigned j = 0; j < 16; ++j) { const unsigned c = xb_ld(&bar[XB_XCNT(j)]); sum += c; cnt += (c > 0u) ? 1u : 0u; mine = (j == x) ? c : mine; }
        if (sum == G) break;
        __builtin_amdgcn_s_sleep(1);
        if ((++sp & 255u) == 0u) { if (xb_ld(&bar[XB_TMO])) break; if (sp > XB_SPIN_CAP) { atomicAdd(&bar[XB_TMO], 1u); break; } }
    }
    nloc = mine > 0u ? mine : 1u; nx = cnt > 0u ? cnt : 1u;
}

__device__ __forceinline__ void xcd_barrier(const XcdBarrier& b, const bool leader_thread) {
    asm volatile("s_waitcnt vmcnt(0)" ::: "memory");
    __syncthreads();
    if (leader_thread) {
        unsigned* bar = b.bar;
        __builtin_amdgcn_s_waitcnt(0);
        unsigned nloc = b.st[0], nx = b.st[1];
        if (nloc == 0u) { xcd_barrier_complete(bar, b.x, nloc, nx); b.st[0] = nloc; b.st[1] = nx; }
        const unsigned old = xb_add(&bar[XB_XSUB(b.x)], 1u);
        const unsigned gen = old / nloc;
        if (old + 1u == (gen + 1u) * nloc) {
            __builtin_amdgcn_fence(__ATOMIC_RELEASE, "agent");
            asm volatile("s_waitcnt vmcnt(0)" ::: "memory");
            const unsigned og = xb_add(&bar[XB_TOP], 1u);
            const unsigned tg = og / nx;
            if (og + 1u == (tg + 1u) * nx) xb_add(&bar[XB_TOPGEN], 1u);
            else XB_SPIN(xb_ld(&bar[XB_TOPGEN]) == tg, bar);
            __builtin_amdgcn_fence(__ATOMIC_ACQUIRE, "agent");
            xb_add(&bar[XB_XGEN(b.x)], 1u);
            asm volatile("s_waitcnt vmcnt(0)" ::: "memory");
        } else {
            XB_SPIN(xb_ld(&bar[XB_XGEN(b.x)]) == gen, bar);
            __builtin_amdgcn_fence(__ATOMIC_ACQUIRE, "agent");
            asm volatile("s_waitcnt vmcnt(0)" ::: "memory");
        }
    }
    __syncthreads();
}

#ifndef MK_PER_PHASE
#define MK_PER_PHASE 0
#endif
__global__ void __launch_bounds__(NWAVES * 64, 2) mega_fwd(Params p_unused) {
    extern __shared__ __attribute__((aligned(16))) unsigned char lds[];
    cg::grid_group grid = cg::this_grid();
    const int G = gridDim.x, NGW = G * NWAVES;
    int lo, hi; { CParams& p = *kargs(); lo = p.lo; hi = p.hi; }
    for (int u = threadIdx.x; u < (LDS_BYTES - LDSCTL_OFF) / 4; u += NWAVES * 64) ((LAS unsigned*)((LAS unsigned char*)lds + LDSCTL_OFF))[u] = 0u;
#if defined(PROBE_POLL)
    if (threadIdx.x == 0) ((volatile LAS unsigned*)((LAS unsigned char*)lds + 131072 + 6144))[0] = 0u;
#endif
    __syncthreads();
    ((volatile LAS unsigned*)((LAS unsigned char*)lds + MISC_OFF + 128))[(int)(__builtin_amdgcn_s_getreg((31 << 11) | 4) & 63u)] = threadIdx.x >> 6;
    __syncthreads();
    (void)xcd_barrier_post((unsigned*)kargs()->ws + CW_BAR, (volatile LAS unsigned*)((LAS unsigned char*)lds + MISC_OFF) + 8);
#define IN(k) (lo <= (k) && (k) < hi)
#define IS_T0() (lane_id_v() == 0 && ((volatile LAS unsigned*)((LAS unsigned char*)lds + MISC_OFF + 128))[(int)(__builtin_amdgcn_s_getreg((31 << 11) | 4) & 63u)] == 0u)
#ifdef PROBE_MASK
#define PRW ((volatile LAS unsigned*)((LAS unsigned char*)lds + MISC_OFF))
    if (threadIdx.x == 0) { PRW[0] = (unsigned)__builtin_amdgcn_s_memrealtime(); PRW[1] = 0u; }
#define PROBE_STAMP(k) do { if (IS_T0()) { const unsigned now_ = (unsigned)__builtin_amdgcn_s_memrealtime(); if (((PROBE_MASK) >> (k)) & 1) PRW[1] += now_ - PRW[0]; PRW[0] = now_; } } while (0)
#else
#define PROBE_STAMP(k) do { } while (0)
#endif
#define SEAM(k) do { if (IN(k) && IN((k) + 1)) { if ((k) == 0 && hi > 1000) grid.sync(); else { XcdBarrier bar; bar.bar = (unsigned*)kargs()->ws + CW_BAR; bar.x = xb_xcc_id(); bar.st = (volatile LAS unsigned*)((LAS unsigned char*)lds + MISC_OFF) + 8; xcd_barrier(bar, IS_T0()); } } PROBE_STAMP(k); } while (0)
#define HWSLOT() ((int)(__builtin_amdgcn_s_getreg((31 << 11) | 4) & 63u))
#define ROOTS() int lane; asm volatile("v_mbcnt_lo_u32_b32 %0, -1, 0\n\tv_mbcnt_hi_u32_b32 %0, -1, %0" : "=v"(lane)); \
    const int wave = __builtin_amdgcn_readfirstlane((int)((volatile LAS unsigned*)((LAS unsigned char*)lds + MISC_OFF + 128))[HWSLOT()]); \
    int tid = wave * 64 + lane; asm volatile("" : "+v"(tid)); const int gw = blockIdx.x * NWAVES + wave; (void)gw; \
    CParams& p = *kargs(); unsigned char* ws = p.ws; bf16* H = (bf16*)(ws + WS_H); bf16* MIX = (bf16*)(ws + WS_MIX); float* RS = (float*)(ws + WS_RS); (void)H; (void)MIX; (void)RS
#define GEMM_PHASE(k, Aptr, LDA, Bptr, LDB, NN, KK, AGRP, Optr, LDC, MODE, RSP) do { if (IN(k)) { ROOTS(); \
        pg8::Gemm g; g.A = (Aptr); g.Bt = (Bptr); g.M = TOK; g.N = (NN); g.K = (KK); g.lda = (LDA); g.ldb = (LDB); g.agrp = (AGRP); \
        pg8::EpiAct E; E.O = (Optr); E.ldc = (LDC); E.mode = (MODE); E.rs = (RSP); \
        pg8::StaticOrder S; S.init(TOK, (NN), G, (int)blockIdx.x); \
        pg8::gemm_phase<pg8::EpiAct, pg8::StaticOrder, true, true>((PG8_LAS unsigned char*)lds, g, S, E, tid); } SEAM(k); } while (0)

#define GEMM_FUSED(k, Aptr, LDA, Bptr, LDB, KK, GPOST, SSQ, OUTF, BANK) do { if (IN(k)) { ROOTS(); \
        pg8::Gemm g; g.A = (Aptr); g.Bt = (Bptr); g.M = TOK; g.N = DMODEL; g.K = (KK); g.lda = (LDA); g.ldb = (LDB); g.agrp = 0; \
        pg8::EpiResNorm E; E.XB = H; E.gpost = (GPOST); E.ssq_out = (SSQ); E.out_f32 = (OUTF); E.xbuf = (float*)(ws + WS_XBUF) + (size_t)(BANK) * TOK * 8; E.cnt = (unsigned*)ws + CW_X + (BANK) * 1024; \
        E.ldsx = (PG8_LAS unsigned char*)lds + 131072; \
        pg8::StaticOrder S; S.init(TOK, DMODEL, G, (int)blockIdx.x); S.wgm = 4; \
        pg8::gemm_phase<pg8::EpiResNorm, pg8::StaticOrder, true, true>((PG8_LAS unsigned char*)lds, g, S, E, tid); } SEAM(k); } while (0)
    if (IN(0)) { ROOTS(); LAS float* scr = (LAS float*)((LAS unsigned char*)lds + wave * TR_WAVE_BYTES);
        for (int z = gw * 64 + lane; z < 3 * TOK; z += NGW * 64) RS[TOK + z] = 0.f;
        convert_weights(p, 0, 1, scr, gw, NGW, lane); row_phase(p.in[0], nullptr, nullptr, nullptr, H, RS, nullptr, gw, NGW, lane); }
    SEAM(0);
    if (IN(1)) { { ROOTS();
        pg8::Gemm g; g.A = H; g.Bt = (bf16*)(ws + WS_WIN); g.M = TOK; g.N = EVEN_IN; g.K = DMODEL; g.lda = DMODEL; g.ldb = DMODEL; g.agrp = 0;
        pg8::EpiAct E; E.O = (bf16*)(ws + WS_PROJ); E.ldc = EVEN_IN; E.mode = 3; E.rs = RS;
        pg8::StaticOrder S; S.init(TOK, EVEN_IN, G, (int)blockIdx.x);
        pg8::gemm_phase<pg8::EpiAct, pg8::StaticOrder, true, true>((PG8_LAS unsigned char*)lds, g, S, E, tid); }
        ROOTS(); (void)tid;
        const int rem = ((TOK / 256) * (EVEN_IN / 256)) % G, c = (int)blockIdx.x;
        LAS float* scr = (LAS float*)((LAS unsigned char*)lds + wave * TR_WAVE_BYTES);
        if (rem == 0) convert_weights(p, 0, 2, scr, gw, NGW, lane);
        else if (c >= rem) convert_weights(p, 0, 2, scr, (c - rem) * NWAVES + wave, (G - rem) * NWAVES, lane);
    }
    SEAM(1);
#ifndef NO_ATT
    if (IN(2)) { ROOTS(); attention_phase(p, (char*)lds, tid); }
#endif
    SEAM(2);
    if (IN(3)) { ROOTS(); diff_combine(p, gw, NGW, lane); }
    SEAM(3);
    GEMM_FUSED(4, (bf16*)(ws + WS_MIXIN), DMODEL, (bf16*)(ws + WS_WOUT), DMODEL, DMODEL, p.in[17], RS + TOK, nullptr, 0);
    GEMM_PHASE(6, H, DMODEL, (bf16*)(ws + WS_W1), DMODEL, DFF, DMODEL, 0, (bf16*)(ws + WS_Z), DFF, 1, RS + TOK);
    GEMM_FUSED(7, (bf16*)(ws + WS_Z), DFF, (bf16*)(ws + WS_W2), DFF, DFF, p.in[19], RS + 2 * TOK, nullptr, 1);
    if (IN(8)) { ROOTS(); LAS float* scr = (LAS float*)((LAS unsigned char*)lds + wave * TR_WAVE_BYTES);
        convert_weights(p, 1, 3, scr, gw, NGW, lane); }
    SEAM(8);
    GEMM_PHASE(9, H, DMODEL, (bf16*)(ws + WS_WIN), DMODEL, ODD_IN, DMODEL, 0, (bf16*)(ws + WS_PROJ), ODD_IN, 2, RS + 2 * TOK);
    if (IN(10)) { ROOTS(); conv_phase(p, blockIdx.x * (NWAVES * 64) + tid, G * NWAVES * 64); }
    SEAM(10);
    GEMM_PHASE(11, (bf16*)p.out, DMODEL, (bf16*)(ws + WS_WG), 256, 4096, 256, 1, (bf16*)(ws + WS_GATES), 4096, 0, nullptr);
#ifndef NO_SCAN
    if (IN(12)) { ROOTS(); scan_phase<1>(p, (LAS unsigned char*)lds, wave, lane); }
    SEAM(12);
    if (IN(13)) { ROOTS(); scan_phase<2>(p, (LAS unsigned char*)lds, wave, lane); }
    SEAM(13);
#endif
    GEMM_FUSED(14, (bf16*)p.out, DMODEL, (bf16*)(ws + WS_WOUT), DMODEL, DMODEL, p.in[17] + DMODEL, RS + 3 * TOK, nullptr, 2);
    GEMM_PHASE(16, H, DMODEL, (bf16*)(ws + WS_W1), DMODEL, DFF, DMODEL, 0, (bf16*)(ws + WS_Z), DFF, 1, RS + 3 * TOK);
    GEMM_FUSED(17, (bf16*)(ws + WS_Z), DFF, (bf16*)(ws + WS_W2), DFF, DFF, p.in[19] + DMODEL, nullptr, p.out, 3);
#if defined(PROBE_POLL)
    if (blockIdx.x == PROBE_POLL && IS_T0()) { asm volatile("s_waitcnt vmcnt(0)" ::: "memory"); kargs()->out[0] += 4.0f * rintf((float)((volatile LAS unsigned*)((LAS unsigned char*)lds + 131072 + 6144))[0] * 0.01f / 4.0f); }
#endif
#ifdef PROBE_MASK
    PROBE_STAMP(18);
    if (blockIdx.x == 0 && IS_T0()) { asm volatile("s_waitcnt vmcnt(0)" ::: "memory"); kargs()->out[0] += (float)(PROBE_Q) * rintf((float)PRW[1] * 0.01f / (float)(PROBE_Q)); }
#endif
#undef IN
#undef SEAM
#undef ROOTS
#undef GEMM_PHASE
#undef GEMM_FUSED
}

extern "C" void kernel_launch(void* const* d_in, const int* in_sizes, int n_in, void* d_out, int out_size, void* d_ws, size_t ws_size, hipStream_t stream) {
    static int grid = 0;
    if (grid == 0) {
        if (n_in != 22 || in_sizes[0] != TOK * DMODEL || out_size != TOK * DMODEL || ws_size < WS_END) { fprintf(stderr, "kernel_launch: unexpected shapes / workspace (n_in %d, in0 %d, out %d, ws %zu)\n", n_in, n_in > 0 ? in_sizes[0] : -1, out_size, ws_size); grid = -1; return; }
        int dev = 0, cus = 0, per_cu = 0;
        if (hipGetDevice(&dev) != hipSuccess || hipDeviceGetAttribute(&cus, hipDeviceAttributeMultiprocessorCount, dev) != hipSuccess) { grid = -1; return; }
        if (hipFuncSetAttribute((const void*)mega_fwd, hipFuncAttributeMaxDynamicSharedMemorySize, LDS_BYTES) != hipSuccess) { fprintf(stderr, "kernel_launch: hipFuncSetAttribute failed\n"); grid = -1; return; }
        if (hipOccupancyMaxActiveBlocksPerMultiprocessor(&per_cu, (const void*)mega_fwd, NWAVES * 64, LDS_BYTES) != hipSuccess || per_cu < 1) { per_cu = 1; (void)hipGetLastError(); }
        grid = cus * per_cu;
        if (grid != 256) { fprintf(stderr, "kernel_launch: the fused residual epilogues need exactly 256 co-resident workgroups (got %d)\n", grid); grid = -1; return; }
    }
    if (grid < 0) return;
    if (hipMemsetAsync(d_ws, 0, CTL_ZERO_BYTES, stream) != hipSuccess) { fprintf(stderr, "kernel_launch: hipMemsetAsync failed\n"); return; }
    Params p{};
    for (int i = 0; i < 22; ++i) p.in[i] = (const float*)d_in[i];
    p.out = (float*)d_out; p.ws = (unsigned char*)d_ws;
#if MK_PER_PHASE
    for (int ph = 0; ph < N_PHASES; ++ph) {
        p.lo = ph; p.hi = ph + 1; void* args[] = {&p};
        hipError_t e = hipLaunchCooperativeKernel((const void*)mega_fwd, dim3(grid), dim3(NWAVES * 64), args, LDS_BYTES, stream);
        if (e != hipSuccess) { fprintf(stderr, "cooperative launch failed: %s (grid %d)\n", hipGetErrorString(e), grid); break; }
    }
#else
    p.lo = 0; p.hi = N_PHASES; void* args[] = {&p};
    hipError_t e = hipLaunchCooperativeKernel((const void*)mega_fwd, dim3(grid), dim3(NWAVES * 64), args, LDS_BYTES, stream);
    if (e != hipSuccess) fprintf(stderr, "cooperative launch failed: %s (grid %d)\n", hipGetErrorString(e), grid);
#endif
}
```

```cpp
#include <hip/hip_runtime.h>
#include <hip/hip_cooperative_groups.h>
#include <cstdio>
#include <cstdint>
namespace cg = cooperative_groups;
namespace pg8 {
#define PG8_LAS __attribute__((address_space(3)))
typedef unsigned short bf16_t;
typedef short bf16x8 __attribute__((ext_vector_type(8)));
typedef float f32x4 __attribute__((ext_vector_type(4)));
typedef unsigned u32x4 __attribute__((ext_vector_type(4)));
constexpr int BM = 256, BK = 64, HALF = 128, HTB = HALF * BK * 2  , STAGE_BYTES = 8 * HTB, NXCD = 8, WGM = 8;

__host__ __device__ __forceinline__ int lds_byte(int r, int c) { const int st = (r >> 4) * 2 + (c >> 5), rr = r & 15, cc = c & 31, ob = rr * 64 + cc * 2; return st * 1024 + (ob ^ (((ob >> 9) & 1) << 5)); }
__host__ __device__ __forceinline__ void stage_rc(int b, int& R, int& C) { const int st = b / 1024, sb = b % 1024, swz = sb ^ (((sb >> 9) & 1) << 5); R = (st >> 1) * 16 + swz / 64; C = (st & 1) * 32 + (swz % 64) / 2; }
__host__ __device__ __forceinline__ int perm32(int rho) { const int n = rho >> 4, i = rho & 15; return 8 * (i >> 2) + 4 * n + (i & 3); }

struct Unit { int pm, pn; };
struct Gemm { const bf16_t* A; const bf16_t* Bt; int M, N, K, lda, ldb, agrp; };

struct StaticOrder {
    int nM, nN, nwg, G, c, wgm;
    __host__ __device__ void init(int M, int N, int G_, int c_) { nM = M / BM; nN = N / BM; nwg = nM * nN; G = G_; c = c_; wgm = WGM; }
    __host__ __device__ bool next(int i, Unit& u) const {
        const long L = (long)i * G + c; if (L >= nwg) return false;
        int wgid = (int)L; { const int q = nwg / NXCD, r = nwg % NXCD, xcd = wgid % NXCD, off = wgid / NXCD; wgid = (xcd < r ? xcd * (q + 1) : r * (q + 1) + (xcd - r) * q) + off; }
        const int nig = wgm * nN, gid = wgid / nig, fm = gid * wgm, gsz = (nM - fm) < wgm ? (nM - fm) : wgm;
        u.pm = fm + ((wgid % nig) % gsz); u.pn = (wgid % nig) / gsz; return true;
    }
    __device__ __forceinline__ void a_ready(const Unit&) const {}
    __device__ __forceinline__ void done(const Unit&) const {}
};

__device__ __forceinline__ unsigned cvt_pk_bf16(float lo, float hi) { unsigned r; asm volatile("v_cvt_pk_bf16_f32 %0, %1, %2" : "=v"(r) : "v"(lo), "v"(hi)); return r; }
__device__ __forceinline__ float act_gelu_tanh(float v) {
    const float u = v * (1.5957691216f + 0.0713548163f * v * v);
    return v * __builtin_amdgcn_rcpf(1.f + __builtin_amdgcn_exp2f(-1.4426950409f * u));
}
constexpr float QSCALE = 0.125f * 1.4426950408889634f;
struct EpiAct {
    static constexpr bool PERM = true, AFTER_DRAIN = false;
    bf16_t* O; int ldc; int mode; const float* rs;
    __device__ __forceinline__ void operator()(const f32x4 (&acc)[2][2][4][2], const Unit& u, int wr, int wc, int fr, int fq) const {
        const int row0 = u.pm * BM + wr * 64 + fr, col0 = u.pn * BM + wc * 32 + 8 * fq;
        int md = mode; float sc = 1.f;
        if (md == 2 && u.pn >= 8) md = 0;
        if (md == 3) { md = 0; if (u.pn < 4 || (u.pn >= 12 && u.pn < 16)) sc = QSCALE; }
#pragma unroll
        for (int ai = 0; ai < 2; ++ai)
#pragma unroll
            for (int m = 0; m < 4; ++m) { bf16_t* rowp = O + (size_t)(row0 + ai * HALF + m * 16) * ldc + col0; const float rsc = rs ? 1.0f / sqrtf(rs[row0 + ai * HALF + m * 16] * (1.0f / 2048.0f) + 1e-6f) : 1.0f;
#pragma unroll
                for (int bj = 0; bj < 2; ++bj) { f32x4 v0 = acc[ai][bj][m][0] * rsc, v1 = acc[ai][bj][m][1] * rsc;
                    if (md == 1) {
#pragma unroll
                        for (int e = 0; e < 4; ++e) { const float a = fmaxf(v0[e], 0.f), b = fmaxf(v1[e], 0.f); v0[e] = a * a; v1[e] = b * b; }
                    } else if (md == 2) {
#pragma unroll
                        for (int e = 0; e < 4; ++e) { v0[e] = act_gelu_tanh(v0[e]); v1[e] = act_gelu_tanh(v1[e]); }
                    }
                    v0 = v0 * sc; v1 = v1 * sc; u32x4 w; w.x = cvt_pk_bf16(v0[0], v0[1]); w.y = cvt_pk_bf16(v0[2], v0[3]); w.z = cvt_pk_bf16(v1[0], v1[1]); w.w = cvt_pk_bf16(v1[2], v1[3]);
                    *(u32x4*)(rowp + bj * HALF) = w; } }
    }
};

struct EpiResNorm {
    static constexpr bool PERM = true, AFTER_DRAIN = false;
    bf16_t* XB; const float* gpost; float* ssq_out; float* out_f32; float* xbuf; unsigned* cnt; PG8_LAS unsigned char* ldsx;
    __device__ __forceinline__ void operator()(f32x4 (&acc)[2][2][4][2], const Unit& u, int wr, int wc, int fr, int fq) const {
        const int wid = wr * 4 + wc, lane = fq * 16 + fr;
        PG8_LAS float* P = (PG8_LAS float*)ldsx;
        PG8_LAS float* S = (PG8_LAS float*)(ldsx + 4096);
        const int colb = u.pn * BM + wc * 32 + 8 * fq;
#pragma unroll
        for (int ai = 0; ai < 2; ++ai)
#pragma unroll
            for (int m = 0; m < 4; ++m) { float s = 0.f;
#pragma unroll
                for (int bj = 0; bj < 2; ++bj)
#pragma unroll
                    for (int n = 0; n < 2; ++n) { const f32x4 x = acc[ai][bj][m][n]; s += (x[0] * x[0] + x[1] * x[1]) + (x[2] * x[2] + x[3] * x[3]); }
                s += __shfl_xor(s, 16); s += __shfl_xor(s, 32);
                if (fq == 0) P[(ai * HALF + wr * 64 + m * 16 + fr) * 4 + wc] = s; }
        asm volatile("s_waitcnt lgkmcnt(0)" ::: "memory"); __builtin_amdgcn_s_barrier(); asm volatile("" ::: "memory");
        const int row = wid * 32 + (lane & 31);
        if (lane < 32) { const float t = (P[row * 4 + 0] + P[row * 4 + 1]) + (P[row * 4 + 2] + P[row * 4 + 3]);
            __hip_atomic_store(xbuf + (size_t)(u.pm * BM + row) * 8 + u.pn, t, __ATOMIC_RELAXED, __HIP_MEMORY_SCOPE_AGENT); }
        asm volatile("s_waitcnt vmcnt(0)" ::: "memory");
        if (lane == 0) __hip_atomic_fetch_add(cnt + 16 * u.pm, 1u, __ATOMIC_RELAXED, __HIP_MEMORY_SCOPE_AGENT);
        u32x4 xbv[4][2];
#pragma unroll
        for (int m = 0; m < 4; ++m)
#pragma unroll
            for (int bj = 0; bj < 2; ++bj) xbv[m][bj] = *(const u32x4*)(XB + (size_t)(u.pm * BM + wr * 64 + m * 16 + fr) * 2048 + colb + bj * HALF);
        f32x4 gv[2][2];
#pragma unroll
        for (int bj = 0; bj < 2; ++bj) { gv[bj][0] = *(const f32x4*)(gpost + colb + bj * HALF); gv[bj][1] = *(const f32x4*)(gpost + colb + bj * HALF + 4); }
        if (wid == 0) { unsigned sp = 0;
#ifdef PROBE_POLL
            const unsigned tp0_ = (unsigned)__builtin_amdgcn_s_memrealtime();
#endif
            while ((unsigned)__builtin_amdgcn_readfirstlane(__hip_atomic_load(cnt + 16 * u.pm, __ATOMIC_RELAXED, __HIP_MEMORY_SCOPE_AGENT)) < 64u) { __builtin_amdgcn_s_sleep(2); if (++sp > (1u << 22)) break; }
            __builtin_amdgcn_fence(__ATOMIC_ACQUIRE, "agent");
#ifdef PROBE_POLL
            if (lane == 0) ((volatile PG8_LAS unsigned*)(ldsx + 6144))[0] += (unsigned)__builtin_amdgcn_s_memrealtime() - tp0_;
#endif
            }
        asm volatile("s_waitcnt vmcnt(0) lgkmcnt(0)" ::: "memory"); __builtin_amdgcn_s_barrier(); asm volatile("" ::: "memory");
        { const int tid_ = wid * 64 + lane, row2 = tid_ >> 1; const float* slot = xbuf + (size_t)(u.pm * BM + row2) * 8 + (tid_ & 1) * 4; float tot = 0.f;
#pragma unroll
            for (int t = 0; t < 4; ++t) tot += __hip_atomic_load(slot + t, __ATOMIC_RELAXED, __HIP_MEMORY_SCOPE_AGENT);
            tot += __shfl_xor(tot, 1);
            if ((tid_ & 1) == 0) S[row2] = 1.0f / sqrtf(tot * (1.0f / 2048.0f) + 1e-6f); }
        asm volatile("s_waitcnt lgkmcnt(0)" ::: "memory"); __builtin_amdgcn_s_barrier(); asm volatile("" ::: "memory");
        float ssv[2][4];
#define PG8_X1(ai) do { _Pragma("unroll") for (int m = 0; m < 4; ++m) { const float r = S[(ai) * HALF + wr * 64 + m * 16 + fr]; float ss = 0.f; \
            _Pragma("unroll") for (int bj = 0; bj < 2; ++bj) { const u32x4 xb = xbv[m][bj]; f32x4 v0 = acc[ai][bj][m][0] * r * gv[bj][0], v1 = acc[ai][bj][m][1] * r * gv[bj][1]; \
                v0[0] += __builtin_bit_cast(float, xb.x << 16); v0[1] += __builtin_bit_cast(float, xb.x & 0xffff0000u); v0[2] += __builtin_bit_cast(float, xb.y << 16); v0[3] += __builtin_bit_cast(float, xb.y & 0xffff0000u); \
                v1[0] += __builtin_bit_cast(float, xb.z << 16); v1[1] += __builtin_bit_cast(float, xb.z & 0xffff0000u); v1[2] += __builtin_bit_cast(float, xb.w << 16); v1[3] += __builtin_bit_cast(float, xb.w & 0xffff0000u); \
                ss += (v0[0] * v0[0] + v0[1] * v0[1]) + (v0[2] * v0[2] + v0[3] * v0[3]) + (v1[0] * v1[0] + v1[1] * v1[1]) + (v1[2] * v1[2] + v1[3] * v1[3]); \
                acc[ai][bj][m][0] = v0; acc[ai][bj][m][1] = v1; } \
            ss += __shfl_xor(ss, 16); ss += __shfl_xor(ss, 32); ssv[ai][m] = ss; } } while (0)
#define PG8_ST(ai) do { _Pragma("unroll") for (int m = 0; m < 4; ++m) { const size_t grow = (size_t)(u.pm * BM + (ai) * HALF + wr * 64 + m * 16 + fr); \
            _Pragma("unroll") for (int bj = 0; bj < 2; ++bj) { const f32x4 v0 = acc[ai][bj][m][0], v1 = acc[ai][bj][m][1]; \
                if (out_f32) { float* op = out_f32 + grow * 2048 + colb + bj * HALF; __builtin_nontemporal_store(v0, (f32x4*)op); __builtin_nontemporal_store(v1, (f32x4*)(op + 4)); } \
                else { u32x4 w; w.x = cvt_pk_bf16(v0[0], v0[1]); w.y = cvt_pk_bf16(v0[2], v0[3]); w.z = cvt_pk_bf16(v1[0], v1[1]); w.w = cvt_pk_bf16(v1[2], v1[3]); *(u32x4*)(XB + grow * 2048 + colb + bj * HALF) = w; } } } } while (0)
        PG8_X1(0);
#pragma unroll
        for (int m = 0; m < 4; ++m)
#pragma unroll
            for (int bj = 0; bj < 2; ++bj) xbv[m][bj] = *(const u32x4*)(XB + (size_t)(u.pm * BM + HALF + wr * 64 + m * 16 + fr) * 2048 + colb + bj * HALF);
        asm volatile("" ::: "memory");
        PG8_ST(0);
        PG8_X1(1);
        PG8_ST(1);
        if (!out_f32 && fq == 0) {
#pragma unroll
            for (int ai = 0; ai < 2; ++ai)
#pragma unroll
                for (int m = 0; m < 4; ++m) atomicAdd(ssq_out + (size_t)(u.pm * BM + ai * HALF + wr * 64 + m * 16 + fr), ssv[ai][m]); }
#undef PG8_X1
#undef PG8_ST
        asm volatile("s_waitcnt vmcnt(0)" ::: "memory");
    }
};
template <class Epi, class Sched, bool ALIGN_EPI = false, bool SP2 = false>
__device__ __forceinline__ void gemm_phase(PG8_LAS unsigned char* lds, const Gemm g, const Sched& S, const Epi& E, const int tid) {
    const int wid = __builtin_amdgcn_readfirstlane(tid >> 6), lane = tid & 63, wr = wid >> 2, wc = wid & 3, fr = lane & 15, fq = lane >> 4;
    const int K = g.K, nt = K / BK;
    unsigned voffA[2], voffB[2];
#pragma unroll
    for (int i = 0; i < 2; ++i) { int R, C; stage_rc(tid * 16 + i * 8192, R, C); const int Rb = Epi::PERM ? ((R & ~31) + perm32(R & 31)) : R;
        voffA[i] = (unsigned)(R * g.lda + C) * 2u; voffB[i] = (unsigned)(Rb * g.ldb + C) * 2u; }
    const size_t kstep = (size_t)(BK * 2);
    const size_t hstepA = (size_t)HALF * g.lda * 2, hstepB = (size_t)HALF * g.ldb * 2;
    const size_t tstepA = 2 * hstepA, tstepB = 2 * hstepB; const size_t agk = g.agrp ? (size_t)K * 2 : 0;
    const unsigned ldsw = (unsigned)wid * 1024u;
    const int aoff = lds_byte(wr * 64 + fr, fq * 8), boff = lds_byte(wc * 32 + fr, fq * 8);
#define PG8_SA(b, h) (((b) * 2 + (h)) * HTB)
#define PG8_SB(b, h) ((4 + (b) * 2 + (h)) * HTB)
#define PG8_STAGE(bufoff, gbase, voff) do { _Pragma("unroll") for (int _i = 0; _i < 2; ++_i) \
        __builtin_amdgcn_global_load_lds((const unsigned*)((const char*)(gbase) + (voff)[_i]), (PG8_LAS unsigned*)(lds + (bufoff) + ldsw + _i * 8192), 16, 0, 0); } while (0)
#define PG8_LDA(dst, b, h) do { _Pragma("unroll") for (int m = 0; m < 4; ++m) _Pragma("unroll") for (int k = 0; k < 2; ++k) dst[m][k] = *(const PG8_LAS bf16x8*)(lds + PG8_SA(b, h) + aoff + m * 2048 + k * 1024); } while (0)
#define PG8_LDB(dst, b, h) do { _Pragma("unroll") for (int n = 0; n < 2; ++n) _Pragma("unroll") for (int k = 0; k < 2; ++k) dst[n][k] = *(const PG8_LAS bf16x8*)(lds + PG8_SB(b, h) + boff + n * 2048 + k * 1024); } while (0)
#define PG8_MMA(ai, bj, At, Bt) do { __builtin_amdgcn_s_setprio(1); _Pragma("unroll") for (int m = 0; m < 4; ++m) _Pragma("unroll") for (int n = 0; n < 2; ++n) _Pragma("unroll") for (int k = 0; k < 2; ++k) \
        acc[ai][bj][m][n] = __builtin_amdgcn_mfma_f32_16x16x32_bf16(Bt[n][k], At[m][k], acc[ai][bj][m][n], 0, 0, 0); __builtin_amdgcn_s_setprio(0); } while (0)
#define PG8_WAIT_V(n) asm volatile("s_waitcnt vmcnt(" #n ")" ::: "memory")
#define PG8_WAIT_L(n) asm volatile("s_waitcnt lgkmcnt(" #n ")" ::: "memory")
#define PG8_BAR __builtin_amdgcn_s_barrier()
#define PG8_SCHED __builtin_amdgcn_sched_barrier(0)
    Unit cur, nxt; int ui = 0;
    if (!S.next(0, cur)) return;
    f32x4 acc[2][2][4][2];
#pragma unroll
    for (int a = 0; a < 2; ++a)
#pragma unroll
        for (int b = 0; b < 2; ++b)
#pragma unroll
            for (int m = 0; m < 4; ++m)
#pragma unroll
                for (int n = 0; n < 2; ++n) acc[a][b][m][n] = (f32x4){0.f, 0.f, 0.f, 0.f};
    bf16x8 At[4][2], B0[2][2], B1[2][2];
    const char* cA = (const char*)g.A + (size_t)cur.pm * tstepA + (size_t)(cur.pn >> 1) * agk; const char* cB = (const char*)g.Bt + (size_t)cur.pn * tstepB;
    S.a_ready(cur);
    if constexpr (SP2) {
        PG8_STAGE(PG8_SB(0, 0), cB, voffB); PG8_STAGE(PG8_SB(0, 1), cB + hstepB, voffB); PG8_STAGE(PG8_SA(0, 0), cA, voffA); PG8_STAGE(PG8_SA(0, 1), cA + hstepA, voffA);
        if (wr == 1) PG8_BAR;
        PG8_WAIT_V(2); PG8_BAR;
        PG8_STAGE(PG8_SB(1, 0), cB + kstep, voffB); PG8_STAGE(PG8_SA(1, 0), cA + kstep, voffA); PG8_STAGE(PG8_SB(1, 1), cB + hstepB + kstep, voffB);
        PG8_WAIT_V(6); PG8_BAR;
    } else {
        PG8_STAGE(PG8_SB(0, 0), cB, voffB); PG8_STAGE(PG8_SA(0, 0), cA, voffA); PG8_STAGE(PG8_SB(0, 1), cB + hstepB, voffB); PG8_STAGE(PG8_SA(0, 1), cA + hstepA, voffA);
        if (wr == 1) PG8_BAR;
        PG8_WAIT_V(4); PG8_BAR;
        PG8_STAGE(PG8_SB(1, 0), cB + kstep, voffB); PG8_STAGE(PG8_SA(1, 0), cA + kstep, voffA); PG8_STAGE(PG8_SB(1, 1), cB + hstepB + kstep, voffB);
        PG8_WAIT_V(6); PG8_BAR;
    }
    for (;;) {
        const bool has_next = S.next(ui + 1, nxt);
        const char* nA = has_next ? (const char*)g.A + (size_t)nxt.pm * tstepA + (size_t)(nxt.pn >> 1) * agk : cA; const char* nB = has_next ? (const char*)g.Bt + (size_t)nxt.pn * tstepB : cB;
        for (int t = 0; t < nt; t += 2) {
            const bool last = (t == nt - 2);
            const char* a1 = cA + (size_t)(t + 1) * kstep;
            const char* a2 = last ? nA : cA + (size_t)(t + 2) * kstep; const char* b2 = last ? nB : cB + (size_t)(t + 2) * kstep;
            const char* a3 = a2 + kstep; const char* b3 = b2 + kstep;
            if (last && has_next) S.a_ready(nxt);
            if constexpr (SP2) {
            PG8_LDB(B0, 0, 0); PG8_LDB(B1, 0, 1); PG8_SCHED; PG8_LDA(At, 0, 0); PG8_STAGE(PG8_SA(1, 1), a1 + hstepA, voffA);
            PG8_WAIT_V(8); PG8_WAIT_L(0); PG8_BAR; PG8_MMA(0, 0, At, B0); PG8_MMA(0, 1, At, B1); PG8_BAR; PG8_SCHED;
            PG8_LDA(At, 0, 1); PG8_STAGE(PG8_SB(0, 0), b2, voffB); PG8_STAGE(PG8_SB(0, 1), b2 + hstepB, voffB); PG8_STAGE(PG8_SA(0, 0), a2, voffA);
            PG8_WAIT_V(8); PG8_WAIT_L(0); PG8_BAR; PG8_MMA(1, 0, At, B0); PG8_MMA(1, 1, At, B1); PG8_BAR; PG8_SCHED;
            PG8_LDB(B0, 1, 0); PG8_LDB(B1, 1, 1); PG8_SCHED; PG8_LDA(At, 1, 0); PG8_STAGE(PG8_SA(0, 1), a2 + hstepA, voffA);
            PG8_WAIT_V(8); PG8_WAIT_L(0); PG8_BAR; PG8_MMA(0, 0, At, B0); PG8_MMA(0, 1, At, B1); PG8_BAR; PG8_SCHED;
            PG8_LDA(At, 1, 1); PG8_STAGE(PG8_SB(1, 0), b3, voffB); PG8_STAGE(PG8_SB(1, 1), b3 + hstepB, voffB); PG8_STAGE(PG8_SA(1, 0), a3, voffA);
            PG8_WAIT_V(8); PG8_WAIT_L(0); PG8_BAR; PG8_MMA(1, 0, At, B0); PG8_MMA(1, 1, At, B1); PG8_BAR; PG8_SCHED;
            } else {
            PG8_LDB(B0, 0, 0); PG8_SCHED; PG8_LDA(At, 0, 0); PG8_STAGE(PG8_SA(1, 1), a1 + hstepA, voffA);
            PG8_WAIT_L(8); PG8_BAR; PG8_WAIT_L(0); PG8_MMA(0, 0, At, B0); PG8_BAR; PG8_SCHED;
            PG8_LDB(B1, 0, 1); PG8_STAGE(PG8_SB(0, 0), b2, voffB);
            PG8_BAR; PG8_WAIT_L(0); PG8_MMA(0, 1, At, B1); PG8_BAR;
            PG8_LDA(At, 0, 1); PG8_STAGE(PG8_SA(0, 0), a2, voffA);
            PG8_BAR; PG8_WAIT_L(0); PG8_MMA(1, 0, At, B0); PG8_BAR; PG8_SCHED;
            PG8_STAGE(PG8_SB(0, 1), b2 + hstepB, voffB);
            PG8_WAIT_V(6); PG8_BAR; PG8_MMA(1, 1, At, B1); PG8_BAR;
            PG8_LDB(B0, 1, 0); PG8_SCHED; PG8_LDA(At, 1, 0); PG8_STAGE(PG8_SA(0, 1), a2 + hstepA, voffA);
            PG8_WAIT_L(8); PG8_BAR; PG8_WAIT_L(0); PG8_MMA(0, 0, At, B0); PG8_BAR; PG8_SCHED;
            PG8_LDB(B1, 1, 1); PG8_STAGE(PG8_SB(1, 0), b3, voffB);
            PG8_BAR; PG8_WAIT_L(0); PG8_MMA(0, 1, At, B1); PG8_BAR;
            PG8_LDA(At, 1, 1); PG8_STAGE(PG8_SA(1, 0), a3, voffA);
            PG8_BAR; PG8_WAIT_L(0); PG8_MMA(1, 0, At, B0); PG8_BAR; PG8_SCHED;
            PG8_STAGE(PG8_SB(1, 1), b3 + hstepB, voffB);
            PG8_WAIT_V(6); PG8_BAR; PG8_MMA(1, 1, At, B1); PG8_BAR;
            }
        }
        if constexpr (ALIGN_EPI) { if (wr == 0) PG8_BAR; }
        if constexpr (!Epi::AFTER_DRAIN) { E(acc, cur, wr, wc, fr, fq); S.done(cur); }
        if (!has_next) break;
#pragma unroll
        for (int a = 0; a < 2; ++a)
#pragma unroll
            for (int b = 0; b < 2; ++b)
#pragma unroll
                for (int m = 0; m < 4; ++m)
#pragma unroll
                    for (int n = 0; n < 2; ++n) acc[a][b][m][n] = (f32x4){0.f, 0.f, 0.f, 0.f};
        cur = nxt; cA = nA; cB = nB; ++ui;
        if constexpr (ALIGN_EPI) { if (wr == 1) PG8_BAR; }
    }
    PG8_WAIT_V(0);
    if constexpr (!ALIGN_EPI) { if (wr == 0) PG8_BAR; }
    PG8_BAR;
    if constexpr (Epi::AFTER_DRAIN) { E.fused(acc, cur, wr, wc, fr, fq, lds, wid, lane); S.done(cur); }
#undef PG8_SA
#undef PG8_SB
#undef PG8_STAGE
#undef PG8_LDA
#undef PG8_LDB
#undef PG8_MMA
#undef PG8_WAIT_V
#undef PG8_WAIT_L
#undef PG8_BAR
#undef PG8_SCHED
}
}
#include <hip/hip_bf16.h>
#include <cmath>
namespace attn_body {
using bf16=__hip_bfloat16;
using bf16x8=__attribute__((ext_vector_type(8)))short;
using s16x4=__attribute__((ext_vector_type(4)))short;
using f32x16=__attribute__((ext_vector_type(16)))float;
using u32x4=__attribute__((ext_vector_type(4)))unsigned;
constexpr int D=64,DM=4352,PO=2048;
constexpr int NW=8,QBLK=32,QB=QBLK*NW,KVBLK=64;
__device__ __forceinline__ int crow(int r,int hi){return (r&3)+8*(r>>2)+4*hi;}
#define SBAR() __builtin_amdgcn_sched_barrier(0)
__device__ __forceinline__ void cmask(f32x16&p0,f32x16&p1,int jb,int qrel,int hi){
  const float NEG=-INFINITY; int kb=64*jb+4*hi;
  #pragma unroll
  for(int r=0;r<16;++r){int kv=kb+(r&3)+8*(r>>2); if(kv>qrel)p0[r]=NEG; if(kv+32>qrel)p1[r]=NEG;}
}

__device__ __forceinline__ void wmask(f32x16&p0,f32x16&p1,int jb,int qrel,int hi){
  const float NEG=-INFINITY; int kb=64*jb+4*hi;
  #pragma unroll
  for(int r=0;r<16;++r){const int dd=qrel-kb-((r&3)+8*(r>>2)); if((unsigned)dd>127u)p0[r]=NEG; if((unsigned)(dd-32)>127u)p1[r]=NEG;}
}
constexpr int NSLOT=3, SLOTB=8192;
constexpr int LDS_K=0, LDS_V=NSLOT*SLOTB, LDS_WS=2*NSLOT*SLOTB, LDS_OST=LDS_WS+NW*64*4, LDS_BYTES=LDS_OST+NW*4096;
constexpr float C2=0.125f*1.4426950408889634f;
__device__ __forceinline__ void glds16(const void*gsrc,unsigned lds_dst){unsigned keep;
  asm volatile("s_mov_b32 %0, m0\n\ts_mov_b32 m0, %2\n\ts_nop 0\n\tglobal_load_lds_dwordx4 %1, off\n\ts_mov_b32 m0, %0":"=&s"(keep):"v"(gsrc),"s"(lds_dst):"memory");}
__device__ __forceinline__ float max3f(float a,float b,float c){float r;asm("v_max3_f32 %0, %1, %2, %3":"=v"(r):"v"(a),"v"(b),"v"(c));return r;}
__device__ __forceinline__ float max2f(float a,float b){float r;asm("v_max_f32_e32 %0, %1, %2":"=v"(r):"v"(a),"v"(b));return r;}
__device__ __forceinline__ float fadd_s(float a,float b){float r;asm("v_add_f32_e32 %0, %1, %2":"=v"(r):"v"(a),"v"(b));return r;}
__device__ __forceinline__ float fsub_s(float a,float b){float r;asm("v_sub_f32_e32 %0, %1, %2":"=v"(r):"v"(a),"v"(b));return r;}
typedef float f32x2_t __attribute__((ext_vector_type(2))); typedef __bf16 bf16x2_t __attribute__((ext_vector_type(2)));
__device__ __forceinline__ unsigned cvtpk_s(float lo,float hi){f32x2_t v={lo,hi};bf16x2_t b=__builtin_convertvector(v,bf16x2_t);return __builtin_bit_cast(unsigned,b);}
#define WAIT_BAR(N) asm volatile("s_waitcnt vmcnt(" #N ") lgkmcnt(0)\n\ts_barrier":::"memory")

__device__ __forceinline__ void qkt(f32x16&p0,f32x16&p1,const char*Kslot,const bf16x8*qr,const f32x16&negm,int r32,int hi){
  const char*kb=Kslot+hi*1024+r32*16;
  #pragma unroll
  for(int d0=0;d0<4;++d0){
    const bf16x8 b0=*reinterpret_cast<const bf16x8*>(kb+d0*2048);
    const bf16x8 b1=*reinterpret_cast<const bf16x8*>(kb+d0*2048+512);
    if(d0==0){p0=__builtin_amdgcn_mfma_f32_32x32x16_bf16(b0,qr[0],negm,0,0,0);p1=__builtin_amdgcn_mfma_f32_32x32x16_bf16(b1,qr[0],negm,0,0,0);}
    else{p0=__builtin_amdgcn_mfma_f32_32x32x16_bf16(b0,qr[d0],p0,0,0,0);p1=__builtin_amdgcn_mfma_f32_32x32x16_bf16(b1,qr[d0],p1,0,0,0);}}
}
typedef __attribute__((address_space(3))) const char* lds_cptr;
typedef short v4i16_t __attribute__((ext_vector_type(4)));
__device__ __forceinline__ void kload8(bf16x8*kf,lds_cptr kp){
  kf[0]=*(const __attribute__((address_space(3))) bf16x8*)(kp);      kf[1]=*(const __attribute__((address_space(3))) bf16x8*)(kp+512);
  kf[2]=*(const __attribute__((address_space(3))) bf16x8*)(kp+2048); kf[3]=*(const __attribute__((address_space(3))) bf16x8*)(kp+2560);
  kf[4]=*(const __attribute__((address_space(3))) bf16x8*)(kp+4096); kf[5]=*(const __attribute__((address_space(3))) bf16x8*)(kp+4608);
  kf[6]=*(const __attribute__((address_space(3))) bf16x8*)(kp+6144); kf[7]=*(const __attribute__((address_space(3))) bf16x8*)(kp+6656);
}
__device__ __forceinline__ void kload2(bf16x8*kf,lds_cptr kp,int j){ kf[2*j]=*(const __attribute__((address_space(3))) bf16x8*)(kp+j*2048); kf[2*j+1]=*(const __attribute__((address_space(3))) bf16x8*)(kp+j*2048+512); }
__device__ __forceinline__ s16x4 vtr(lds_cptr p){ return __builtin_bit_cast(s16x4,__builtin_amdgcn_ds_read_tr16_b64_v4i16((__attribute__((address_space(3))) v4i16_t*)p)); }
__device__ __forceinline__ float rowmax(const f32x16&p0,const f32x16&p1){
  float a=max3f(p0[0],p0[1],p1[0]),b=max3f(p0[2],p0[3],p1[1]);a=max3f(a,p1[2],p1[3]);
  #pragma unroll
  for(int r=4;r<16;r+=4){a=max3f(a,p0[r],p0[r+1]);b=max3f(b,p0[r+2],p0[r+3]);a=max3f(a,p1[r],p1[r+1]);b=max3f(b,p1[r+2],p1[r+3]);}
  const float m=max2f(a,b);
  auto rr=__builtin_amdgcn_permlane32_swap(__float_as_uint(m),__float_as_uint(m),false,false);
  return max2f(__uint_as_float(rr[0]),__uint_as_float(rr[1]));
}
__device__ __forceinline__ void pv(f32x16*o,int vb,bf16x8 pa0,bf16x8 pa1,bf16x8 pa2,bf16x8 pa3){
  #pragma unroll
  for(int d0=0;d0<2;++d0){s16x4 lo[4],hi[4];
    #pragma unroll
    for(int ks=0;ks<4;++ks){
      asm volatile("ds_read_b64_tr_b16 %0,%1 offset:%c2":"=&v"(lo[ks]):"v"(vb),"i"(d0*4096+ks*1024):"memory");
      asm volatile("ds_read_b64_tr_b16 %0,%1 offset:%c2":"=&v"(hi[ks]):"v"(vb),"i"(d0*4096+ks*1024+512):"memory");}
    asm volatile("s_waitcnt lgkmcnt(0)":::"memory");SBAR();
    #define PK(k) (bf16x8){lo[k][0],lo[k][1],lo[k][2],lo[k][3],hi[k][0],hi[k][1],hi[k][2],hi[k][3]}
    o[d0]=__builtin_amdgcn_mfma_f32_32x32x16_bf16(pa0,PK(0),o[d0],0,0,0);
    o[d0]=__builtin_amdgcn_mfma_f32_32x32x16_bf16(pa1,PK(1),o[d0],0,0,0);
    o[d0]=__builtin_amdgcn_mfma_f32_32x32x16_bf16(pa2,PK(2),o[d0],0,0,0);
    o[d0]=__builtin_amdgcn_mfma_f32_32x32x16_bf16(pa3,PK(3),o[d0],0,0,0);
    #undef PK
  }
}

#ifndef ATTN_STORE16
#define ATTN_STORE16(p,v) (*(u32x4*)(p)=(v))
#endif
template<int THRL> __device__ __forceinline__ void attn_unit(const bf16*Qp,const bf16*__restrict__ Kp,const bf16*__restrict__ Vp,bf16*Op,int q0,int t0,const bool SWA,float sink_l2,char*shm,const int tid){
  const int lane=tid&63,r32=lane&31,hi=lane>>5; const int wid=__builtin_amdgcn_readfirstlane(tid>>6);
  const bf16*Qw=Qp+(long)(q0+wid*QBLK)*DM;
  const bf16*Kh=Kp+(long)t0*KVBLK*DM,*Vh=Vp+(long)t0*KVBLK*DM;
  const unsigned lds0=(unsigned)(uintptr_t)shm;
  float*wsf=(float*)(shm+LDS_WS)+wid*64;
  const bf16*ksrc=Kh+(long)lane*DM+wid*8;
  const bf16*vsrc=Vh+(long)(16*(wid&3)+(lane>>2))*DM+(wid>>2)*32+(lane&3)*8;
  const unsigned kdst=lds0+LDS_K+wid*1024, vdst=lds0+LDS_V+wid*1024;
  #define DMA_K(t,slot) glds16(ksrc+(long)(t)*KVBLK*DM,(unsigned)__builtin_amdgcn_readfirstlane(kdst+(slot)))
  #define DMA_V(t,slot) glds16(vsrc+(long)(t)*KVBLK*DM,(unsigned)__builtin_amdgcn_readfirstlane(vdst+(slot)))
  const int vb0=(int)(lds0+LDS_V)+((lane>>4)&1)*32+(lane&3)*8+(4*hi+((lane&15)>>2))*64;
  const char*Kbase=shm+LDS_K; bf16x8 kf[8];
  const lds_cptr shm3=(lds_cptr)shm; const lds_cptr kp0=shm3+LDS_K+hi*1024+r32*16; const lds_cptr vp0=shm3+LDS_V+((lane>>4)&1)*32+(lane&3)*8+(4*hi+((lane&15)>>2))*64;
  const int NT=(q0+QB)/KVBLK-t0;
  DMA_K(0,0);DMA_V(0,0);DMA_K(1,SLOTB);
  bf16x8 qr[4];
  #pragma unroll
  for(int d0=0;d0<4;++d0)qr[d0]=*reinterpret_cast<const bf16x8*>(&Qw[(long)r32*DM+d0*16+hi*8]);
  float mhat=0.f,l_reg=0.f;f32x16 o[2];o[0]=f32x16{};o[1]=f32x16{};f32x16 negm=f32x16{};asm volatile("":"+v"(negm));
  const int qrel=wid*QBLK+r32;
  #define CMASK(P0,P1,t) do{int jb_=(t)-(NT-4); if(SWA)wmask(P0,P1,jb_,qrel,hi); else if(jb_>=0)cmask(P0,P1,jb_,qrel,hi);}while(0)
  bool resc=false;
  #define START(P0,P1) do{ const float rm=rowmax(P0,P1); resc=false; \
    { const float dl=SWA?max2f(rm,sink_l2):rm; mhat=fadd_s(mhat,dl); if(SWA)l_reg=hi?0.f:__builtin_amdgcn_exp2f(sink_l2-dl); \
      _Pragma("unroll") for(int r=0;r<16;++r){P0[r]=fsub_s(P0[r],dl);P1[r]=fsub_s(P1[r],dl);} \
      _Pragma("unroll") for(int r=0;r<16;++r)negm[r]=-mhat; asm volatile("":"+v"(negm)); } \
    _Pragma("unroll") for(int r=0;r<16;++r)P0[r]=__builtin_amdgcn_exp2f(P0[r]); }while(0)
  #define RESC() do{ if(resc){ asm volatile("s_waitcnt lgkmcnt(0)":::"memory"); \
      _Pragma("unroll") for(int d_=0;d_<2;++d_) _Pragma("unroll") for(int r=0;r<16;++r)o[d_][r]*=wsf[crow(r,hi)]; } }while(0)
  f32x16 pA0,pA1,pB0,pB1;
  int sl_prev=0,sl_cur=0,sl_next=SLOTB;
  #define ROT() do{sl_prev=sl_cur;sl_cur=sl_next;sl_next=(sl_next==(NSLOT-1)*SLOTB)?0:sl_next+SLOTB;}while(0)
  DMA_K(2,2*SLOTB);
  WAIT_BAR(3);
  qkt(pA0,pA1,Kbase,qr,negm,r32,hi);asm volatile("s_nop 15\n\ts_nop 7":"+v"(pA0),"+v"(pA1));CMASK(pA0,pA1,0);
  START(pA0,pA1);
  _Pragma("unroll") for(int r=0;r<16;++r)pA1[r]=__builtin_amdgcn_exp2f(pA1[r]);
  WAIT_BAR(0);
  DMA_K(3,0);DMA_V(1,SLOTB);
  ROT();
  kload8(kf,kp0+sl_cur);
  WAIT_BAR(2);
  s16x4 vlo[8],vhi[8]; u32x4 pw0,pw1,pw2,pw3;
  #define PKW(P,B) cvtpk_s(P[B],P[B+1])
  #define PAF(k) __builtin_bit_cast(bf16x8,pw##k)
  #define VFR(i) (bf16x8){vlo[i][0],vlo[i][1],vlo[i][2],vlo[i][3],vhi[i][0],vhi[i][1],vhi[i][2],vhi[i][3]}
  #define PIN(x) asm volatile("":"+v"(x))
  #define MX3(a,b,c) __builtin_fmaxf(__builtin_fmaxf((a),(b)),(c))
  #define GAPA(MF,A0,A1,A2,A3,W0,W1,PW) do{ MF; sacc+=A0; sacc+=A1; sacc+=A2; sacc+=A3; PIN(sacc); W0; W1; PIN(PW); SBAR(); }while(0)
  #define EX(v) __builtin_amdgcn_exp2f(v)
  #define GAPB(MF,X,B) do{ MF; X[B]=EX(X[B]); X[B+1]=EX(X[B+1]); X[B+2]=EX(X[B+2]); X[B+3]=EX(X[B+3]); PIN(X); SBAR(); }while(0)
  #define VRD(i) do{ vlo[i]=vtr(vp_+(((i)>>2)*4096+((i)&3)*1024)); vhi[i]=vtr(vp_+(((i)>>2)*4096+((i)&3)*1024+512)); }while(0)
  #define KRD(G,j) do{ if(G){ kload2(kf,kp0+sl_next,j); SBAR(); } }while(0)
  #define STEP(C0,C1,P0,P1,t,GK,GV,GL) do{ SBAR(); \
    const lds_cptr vp_=vp0+sl_prev; \
    VRD(0); SBAR(); float sacc=(P0[0]+P0[1]); \
    GAPA(C0=__builtin_amdgcn_mfma_f32_32x32x16_bf16(kf[0],qr[0],negm,0,0,0), P0[2],P0[3],P0[4],P0[5],     pw0[0]=PKW(P0,0), pw0[1]=PKW(P0,2), pw0); \
    VRD(4); SBAR(); GAPA(C1=__builtin_amdgcn_mfma_f32_32x32x16_bf16(kf[1],qr[0],negm,0,0,0), P0[6],P0[7],P0[8],P0[9],     pw0[2]=PKW(P0,4), pw0[3]=PKW(P0,6), pw0); \
    VRD(1); SBAR(); GAPA(C0=__builtin_amdgcn_mfma_f32_32x32x16_bf16(kf[2],qr[1],C0,0,0,0),   P0[10],P0[11],P0[12],P0[13], pw1[0]=PKW(P0,8), pw1[1]=PKW(P0,10), pw1); \
    VRD(5); SBAR(); GAPA(C1=__builtin_amdgcn_mfma_f32_32x32x16_bf16(kf[3],qr[1],C1,0,0,0),   P0[14],P0[15],P1[0],P1[1],   pw1[2]=PKW(P0,12),pw1[3]=PKW(P0,14), pw1); \
    VRD(2); SBAR(); GAPA(C0=__builtin_amdgcn_mfma_f32_32x32x16_bf16(kf[4],qr[2],C0,0,0,0),   P1[2],P1[3],P1[4],P1[5],     pw2[0]=PKW(P1,0), pw2[1]=PKW(P1,2), pw2); \
    VRD(6); SBAR(); GAPA(C1=__builtin_amdgcn_mfma_f32_32x32x16_bf16(kf[5],qr[2],C1,0,0,0),   P1[6],P1[7],P1[8],P1[9],     pw2[2]=PKW(P1,4), pw2[3]=PKW(P1,6), pw2); \
    VRD(3); SBAR(); GAPA(C0=__builtin_amdgcn_mfma_f32_32x32x16_bf16(kf[6],qr[3],C0,0,0,0),   P1[10],P1[11],P1[12],P1[13], pw3[0]=PKW(P1,8), pw3[1]=PKW(P1,10), pw3); \
    VRD(7); SBAR(); GAPA(C1=__builtin_amdgcn_mfma_f32_32x32x16_bf16(kf[7],qr[3],C1,0,0,0),   P1[14],P1[15],0.f,0.f,       pw3[2]=PKW(P1,12),pw3[3]=PKW(P1,14), pw3); \
    l_reg+=sacc; \
    if(GK){DMA_K((t)+3,sl_cur);} if(GV){DMA_V((t)+1,sl_next);} \
    CMASK(C0,C1,t); \
    { float a=MX3(C0[0],C0[1],C1[0]),b=MX3(C0[2],C0[3],C1[1]); a=MX3(a,C1[2],C1[3]); \
      _Pragma("unroll") for(int r=4;r<16;r+=4){a=MX3(a,C0[r],C0[r+1]);b=MX3(b,C0[r+2],C0[r+3]);a=MX3(a,C1[r],C1[r+1]);b=MX3(b,C1[r+2],C1[r+3]);} \
      float rm=__builtin_fmaxf(a,b); { auto rr=__builtin_amdgcn_permlane32_swap(__float_as_uint(rm),__float_as_uint(rm),false,false); rm=__builtin_fmaxf(__uint_as_float(rr[0]),__uint_as_float(rr[1])); } \
      resc=false; \
      if(__builtin_expect(__any(rm>(float)THRL),0)){ const float dl=__builtin_fmaxf(rm,0.f); mhat+=dl; \
        _Pragma("unroll") for(int r=0;r<16;++r){C0[r]-=dl;C1[r]-=dl;} \
        _Pragma("unroll") for(int r=0;r<16;++r)negm[r]=-mhat; asm volatile("":"+v"(negm)); \
        const float f=__builtin_amdgcn_exp2f(-dl); l_reg*=f; if(hi==0)wsf[r32]=f; resc=true; } } \
    SBAR(); \
    GAPB(o[0]=__builtin_amdgcn_mfma_f32_32x32x16_bf16(PAF(0),VFR(0),o[0],0,0,0), C0,0); \
    GAPB(o[1]=__builtin_amdgcn_mfma_f32_32x32x16_bf16(PAF(0),VFR(4),o[1],0,0,0), C0,4); \
    KRD(GL,0); GAPB(o[0]=__builtin_amdgcn_mfma_f32_32x32x16_bf16(PAF(1),VFR(1),o[0],0,0,0), C0,8); \
    KRD(GL,1); GAPB(o[1]=__builtin_amdgcn_mfma_f32_32x32x16_bf16(PAF(1),VFR(5),o[1],0,0,0), C0,12); \
    KRD(GL,2); GAPB(o[0]=__builtin_amdgcn_mfma_f32_32x32x16_bf16(PAF(2),VFR(2),o[0],0,0,0), C1,0); \
    KRD(GL,3); GAPB(o[1]=__builtin_amdgcn_mfma_f32_32x32x16_bf16(PAF(2),VFR(6),o[1],0,0,0), C1,4); \
    GAPB(o[0]=__builtin_amdgcn_mfma_f32_32x32x16_bf16(PAF(3),VFR(3),o[0],0,0,0), C1,8); \
    GAPB(o[1]=__builtin_amdgcn_mfma_f32_32x32x16_bf16(PAF(3),VFR(7),o[1],0,0,0), C1,12); \
    }while(0)
  int t=1;
  #undef CMASK
  #define CMASK(P0,P1,t) do{}while(0)
  for(;t+5<NT;t+=2){
    STEP(pB0,pB1,pA0,pA1,t,true,true,true);     WAIT_BAR(2); RESC(); ROT();
    STEP(pA0,pA1,pB0,pB1,t+1,true,true,true);   WAIT_BAR(2); RESC(); ROT();
  }
  #undef CMASK
  #define CMASK(P0,P1,t) do{int jb_=(t)-(NT-4); if(SWA)wmask(P0,P1,jb_,qrel,hi); else if(jb_>=0)cmask(P0,P1,jb_,qrel,hi);}while(0)
  #define ENDW(tt) do{ if((tt)+3<NT){WAIT_BAR(2);} else if((tt)+2<NT){WAIT_BAR(1);} else {WAIT_BAR(0);} }while(0)
  for(;t+1<NT;t+=2){
    STEP(pB0,pB1,pA0,pA1,t,(t+3<NT),(t+1<NT),(t+1<NT));       ENDW(t);   RESC(); ROT();
    STEP(pA0,pA1,pB0,pB1,t+1,(t+4<NT),(t+2<NT),(t+2<NT));     ENDW(t+1); RESC(); ROT();
  }
  STEP(pB0,pB1,pA0,pA1,NT-1,false,false,false); RESC();
  { float sacc=pB0[0]+pB0[1]; _Pragma("unroll") for(int r=2;r<16;++r)sacc+=pB0[r]; _Pragma("unroll") for(int r=0;r<16;++r)sacc+=pB1[r]; l_reg+=sacc;
    pw0=(u32x4){PKW(pB0,0),PKW(pB0,2),PKW(pB0,4),PKW(pB0,6)};pw1=(u32x4){PKW(pB0,8),PKW(pB0,10),PKW(pB0,12),PKW(pB0,14)};pw2=(u32x4){PKW(pB1,0),PKW(pB1,2),PKW(pB1,4),PKW(pB1,6)};pw3=(u32x4){PKW(pB1,8),PKW(pB1,10),PKW(pB1,12),PKW(pB1,14)};
    SBAR(); pv(o,vb0+sl_cur,PAF(0),PAF(1),PAF(2),PAF(3)); }
  #undef PKW
  #undef PAF
  #undef VFR
  #undef PIN
  #undef MX3
  #undef GAPA
  #undef GAPB
  #undef EX
  #undef VRD
  #undef KRD
  #undef STEP
  #undef ENDW
  {auto rr=__builtin_amdgcn_permlane32_swap(__float_as_uint(l_reg),__float_as_uint(l_reg),false,false);l_reg=__uint_as_float(rr[0])+__uint_as_float(rr[1]);}
  if(hi==0)wsf[32+r32]=l_reg;asm volatile("s_waitcnt lgkmcnt(0)":::"memory");
  float rli[16];
  #pragma unroll
  for(int r=0;r<16;++r)rli[r]=__builtin_amdgcn_rcpf(wsf[32+crow(r,hi)]);
  bf16*Ow=Op+(long)(q0+wid*QBLK)*PO;
  { bf16*stg=(bf16*)(shm+LDS_OST)+wid*2048;
    #pragma unroll
    for(int r=0;r<16;++r){const int orow=crow(r,hi);
      #pragma unroll
      for(int d0=0;d0<2;++d0)stg[orow*64+d0*32+r32]=__float2bfloat16(o[d0][r]*rli[r]);}
    asm volatile("s_waitcnt lgkmcnt(0)":::"memory");
    #pragma unroll
    for(int i=0;i<4;++i){const int row=i*8+(lane>>3),ch=lane&7; const u32x4 v=*(const u32x4*)(stg+row*64+ch*8); ATTN_STORE16(Ow+(long)row*PO+ch*8,v);} }
  asm volatile("s_waitcnt lgkmcnt(0)\n\ts_barrier":::"memory");
  #undef DMA_K
  #undef DMA_V
  #undef CMASK
  #undef START
  #undef RESC
  #undef ROT
}
constexpr int ATTN_LDS_BYTES=LDS_BYTES;
#undef SBAR
#undef WAIT_BAR
}
constexpr int NWAVES = 8;
constexpr int TOK = 16384, SEQL = 4096, DMODEL = 2048, EVEN_IN = 4352, ODD_IN = 4096, DFF = 8192;
constexpr float EPSN = 1e-6f;
constexpr float LOG2E = 1.4426950408889634f;
constexpr size_t MiB = 1u << 20;
constexpr size_t WS_WIN = 1 * MiB, WS_WOUT = 18 * MiB, WS_W1 = 26 * MiB, WS_W2 = 58 * MiB, WS_WG = 90 * MiB;
constexpr size_t WS_H = 92 * MiB;
constexpr size_t WS_RS = 128 * 1024;
constexpr size_t WS_XBUF = 220 * MiB;
constexpr int CW_X = 8192;
constexpr size_t WS_MIX = 156 * MiB;
constexpr size_t WS_CARRY = 156 * MiB;
constexpr size_t WS_R = 224 * MiB;
constexpr size_t WS_PROJ = WS_R;
constexpr size_t WS_ATT = WS_R + 136 * MiB;
constexpr size_t WS_MIXIN = WS_R + 200 * MiB;
constexpr size_t WS_Z = WS_R;
constexpr size_t WS_GATES = WS_R + 128 * MiB;
constexpr size_t WS_END = WS_R + 264 * MiB;
constexpr int LDS_BYTES = 147456;
constexpr int N_PHASES = 19;
constexpr int LDSCTL_OFF = 144384, MISC_OFF = LDSCTL_OFF + 320;

typedef unsigned short bf16;
typedef unsigned v4u __attribute__((ext_vector_type(4)));
typedef unsigned v2u __attribute__((ext_vector_type(2)));
typedef float f32x4 __attribute__((ext_vector_type(4)));
#define LAS __attribute__((address_space(3)))
#define LDS_WAIT() asm volatile("s_waitcnt lgkmcnt(0)" ::: "memory")
__device__ __forceinline__ unsigned f2bf(float f) { unsigned u = __builtin_bit_cast(unsigned, f); return (u + 0x7fffu + ((u >> 16) & 1u)) >> 16; }
__device__ __forceinline__ unsigned pk2(float lo, float hi) { return f2bf(lo) | (f2bf(hi) << 16); }
__device__ __forceinline__ float bflo(unsigned w) { return __builtin_bit_cast(float, w << 16); }
__device__ __forceinline__ float bfhi(unsigned w) { return __builtin_bit_cast(float, w & 0xffff0000u); }
#define UNPK8(dst, v) do { dst[0] = bflo((v).x); dst[1] = bfhi((v).x); dst[2] = bflo((v).y); dst[3] = bfhi((v).y); dst[4] = bflo((v).z); dst[5] = bfhi((v).z); dst[6] = bflo((v).w); dst[7] = bfhi((v).w); } while (0)
__device__ __forceinline__ float wave_sum(float v) {
#pragma unroll
    for (int o = 1; o < 64; o <<= 1) v += __shfl_xor(v, o);
    return v;
}
__device__ __forceinline__ int lane_id_v() { int l; asm volatile("v_mbcnt_lo_u32_b32 %0, -1, 0\n\tv_mbcnt_hi_u32_b32 %0, -1, %0" : "=v"(l)); return l; }
__device__ __forceinline__ float sigmoidf_(float x) { return __builtin_amdgcn_rcpf(1.f + __builtin_amdgcn_exp2f(-LOG2E * x)); }

constexpr int TR_LD = 65, TR_WAVE_BYTES = 64 * TR_LD * 4;
__device__ __forceinline__ void transpose_item(const float* W, int K, int N, bf16* WT, int row_off, LAS float* scr, int item, int lane, const float* gk = nullptr) {
    const int nblk = N / 64, kb = item / nblk, nb = item % nblk, k0 = 64 * kb, n0 = 64 * nb;
    const int n4 = (lane & 15) * 4, kr = lane >> 4;
    f32x4 v[16];
#pragma unroll
    for (int i = 0; i < 16; ++i) v[i] = __builtin_nontemporal_load((const f32x4*)(W + (size_t)(k0 + 4 * i + kr) * N + n0 + n4));
#pragma unroll
    for (int i = 0; i < 16; ++i) { LAS float* d = scr + (4 * i + kr) * TR_LD + n4; const float gs = gk ? gk[k0 + 4 * i + kr] : 1.0f; d[0] = v[i].x * gs; d[1] = v[i].y * gs; d[2] = v[i].z * gs; d[3] = v[i].w * gs; }
    LDS_WAIT(); asm volatile("" ::: "memory");
    const int c = lane & 7;
#pragma unroll
    for (int j = 0; j < 8; ++j) { const int n = (lane >> 3) + 8 * j; const LAS float* s = scr + (8 * c) * TR_LD + n;
        v4u o; o.x = pk2(s[0 * TR_LD], s[1 * TR_LD]); o.y = pk2(s[2 * TR_LD], s[3 * TR_LD]); o.z = pk2(s[4 * TR_LD], s[5 * TR_LD]); o.w = pk2(s[6 * TR_LD], s[7 * TR_LD]);
        *(v4u*)(WT + (size_t)(row_off + n0 + n) * K + k0 + 8 * c) = o; }
    LDS_WAIT(); asm volatile("" ::: "memory");
}

struct Params { const float* in[22]; float* out; unsigned char* ws; int lo, hi; };
typedef const __attribute__((address_space(4))) Params CParams;
__device__ __forceinline__ CParams* kargs() { CParams* kp = (CParams*)__builtin_amdgcn_kernarg_segment_ptr(); asm volatile("" : "+s"(kp)); return kp; }

__device__ __forceinline__ void convert_weights(CParams& p, int layer, int which  , LAS float* scr, int gw, int NGW, int lane) {
    unsigned char* ws = p.ws;
    const int I_IN = (layer == 0) ? 32 * (EVEN_IN / 64) : 32 * (ODD_IN / 64), I_OUT = 32 * 32, I_1 = 32 * 128, I_2 = 128 * 32, I_G = (layer == 0) ? 0 : 16 * 16;
    const int NIT = I_IN + I_OUT + I_1 + I_2 + I_G;
    const int it_lo = (which & 2) ? 0 : I_1 + I_OUT, it_hi = (which & 1) ? NIT : I_1 + I_OUT;
    const float* win = (layer == 0) ? p.in[1] : p.in[9]; const int nin = (layer == 0) ? EVEN_IN : ODD_IN;
    const float* wout = (layer == 0) ? p.in[8] : p.in[15];
    const float* w1 = p.in[20] + (size_t)layer * DMODEL * DFF; const float* w2 = p.in[21] + (size_t)layer * DFF * DMODEL;
    for (int it = it_lo + gw; it < it_hi; it += NGW) {
        int r = it;
        if (r < I_1) { transpose_item(w1, DMODEL, DFF, (bf16*)(ws + WS_W1), 0, scr, r, lane, p.in[18] + layer * DMODEL); continue; } r -= I_1;
        if (r < I_OUT) { transpose_item(wout, DMODEL, DMODEL, (bf16*)(ws + WS_WOUT), 0, scr, r, lane); continue; } r -= I_OUT;
        if (r < I_2) { transpose_item(w2, DFF, DMODEL, (bf16*)(ws + WS_W2), 0, scr, r, lane); continue; } r -= I_2;
        if (r < I_IN) { transpose_item(win, DMODEL, nin, (bf16*)(ws + WS_WIN), 0, scr, r, lane, p.in[16] + layer * DMODEL); continue; } r -= I_IN;
        { const int gn = r >> 4, g = gn >> 3, n = gn & 7;
          transpose_item(p.in[12] + (size_t)gn * 65536, 256, 256, (bf16*)(ws + WS_WG), n * 512 + g * 256, scr, r & 15, lane); }
    }
}

__device__ __forceinline__ void row_phase(const float* xin, const bf16* xb_in, const bf16* y, const float* gpost, bf16* xb_out, float* rs, float* out_f32, int gw, int NGW, int lane) {
    for (int m = gw; m < TOK; m += NGW) {
        f32x4 v[8];
        if (xin) { const f32x4* xr = (const f32x4*)(xin + (size_t)m * DMODEL) + lane;
#pragma unroll
            for (int j = 0; j < 8; ++j) v[j] = __builtin_nontemporal_load(xr + 64 * j); }
        else { const v2u* xr = (const v2u*)(xb_in + (size_t)m * DMODEL) + lane;
#pragma unroll
            for (int j = 0; j < 8; ++j) { const v2u w = xr[64 * j]; v[j] = (f32x4){bflo(w.x), bfhi(w.x), bflo(w.y), bfhi(w.y)}; } }
        if (y) {
            const v2u* yr = (const v2u*)(y + (size_t)m * DMODEL) + lane; v2u yy[8]; float ss = 0.f;
#pragma unroll
            for (int j = 0; j < 8; ++j) { yy[j] = yr[64 * j]; const float a = bflo(yy[j].x), b = bfhi(yy[j].x), c = bflo(yy[j].y), d = bfhi(yy[j].y); ss += (a * a + b * b) + (c * c + d * d); }
            const float r = 1.0f / sqrtf(wave_sum(ss) * (1.f / DMODEL) + EPSN);
#pragma unroll
            for (int j = 0; j < 8; ++j) { const f32x4 g = ((const f32x4*)gpost)[64 * j + lane];
                v[j].x += bflo(yy[j].x) * r * g.x; v[j].y += bfhi(yy[j].x) * r * g.y; v[j].z += bflo(yy[j].y) * r * g.z; v[j].w += bfhi(yy[j].y) * r * g.w; }
        }
        if (out_f32) { f32x4* xo = (f32x4*)(out_f32 + (size_t)m * DMODEL) + lane;
#pragma unroll
            for (int j = 0; j < 8; ++j) __builtin_nontemporal_store(v[j], xo + 64 * j); }
        if (xb_out) {
            float ss = 0.f;
#pragma unroll
            for (int j = 0; j < 8; ++j) ss += (v[j].x * v[j].x + v[j].y * v[j].y) + (v[j].z * v[j].z + v[j].w * v[j].w);
            const float tot = wave_sum(ss);
            if (lane == 0) rs[m] = tot;
            v2u* ho = (v2u*)(xb_out + (size_t)m * DMODEL) + lane;
#pragma unroll
            for (int j = 0; j < 8; ++j) { v2u o; o.x = pk2(v[j].x, v[j].y); o.y = pk2(v[j].z, v[j].w); ho[64 * j] = o; }
        }
    }
}

__device__ __forceinline__ void diff_combine(CParams& p, int gw, int NGW, int lane) {
    const bf16* att = (const bf16*)(p.ws + WS_ATT); bf16* mixin = (bf16*)(p.ws + WS_MIXIN);
    const float s1 = wave_sum(p.in[2][lane] * p.in[3][lane]), s2 = wave_sum(p.in[4][lane] * p.in[5][lane]);
    const float lambda_init = 0.2f;
    const float lam = expf(s1) - expf(s2) + lambda_init;
    const int l16 = lane & 15, hsub = lane >> 4;
    float g[8];
#pragma unroll
    for (int k = 0; k < 8; ++k) g[k] = p.in[6][l16 * 8 + k] * (1.0f - lambda_init);
    for (int it0 = gw; it0 < TOK * 2; it0 += 4 * NGW) {
      v4u av[4], bv[4];
#pragma unroll
      for (int q = 0; q < 4; ++q) { const int it = (it0 + q * NGW < TOK * 2) ? it0 + q * NGW : it0; const int t = it >> 1, h = (it & 1) * 4 + hsub;
        av[q] = *(const v4u*)(att + (size_t)t * 2048 + 256 * h + l16 * 8); bv[q] = *(const v4u*)(att + (size_t)t * 2048 + 256 * h + 128 + l16 * 8); }
#pragma unroll
      for (int q = 0; q < 4; ++q) { const int it = it0 + q * NGW; if (it >= TOK * 2) break;
        const int t = it >> 1, h = (it & 1) * 4 + hsub;
        const v4u a = av[q], b = bv[q];
        float v[8];
        v[0] = bflo(a.x) - lam * bflo(b.x); v[1] = bfhi(a.x) - lam * bfhi(b.x); v[2] = bflo(a.y) - lam * bflo(b.y); v[3] = bfhi(a.y) - lam * bfhi(b.y);
        v[4] = bflo(a.z) - lam * bflo(b.z); v[5] = bfhi(a.z) - lam * bfhi(b.z); v[6] = bflo(a.w) - lam * bflo(b.w); v[7] = bfhi(a.w) - lam * bfhi(b.w);
        float ss = 0.f;
#pragma unroll
        for (int k = 0; k < 8; ++k) ss += v[k] * v[k];
        ss += __shfl_xor(ss, 1); ss += __shfl_xor(ss, 2); ss += __shfl_xor(ss, 4); ss += __shfl_xor(ss, 8);
        const float r = 1.0f / sqrtf(ss * (1.f / 128.f) + EPSN);
        v4u o; o.x = pk2(v[0] * r * g[0], v[1] * r * g[1]); o.y = pk2(v[2] * r * g[2], v[3] * r * g[3]); o.z = pk2(v[4] * r * g[4], v[5] * r * g[5]); o.w = pk2(v[6] * r * g[6], v[7] * r * g[7]);
        *(v4u*)(mixin + (size_t)t * 2048 + 128 * h + l16 * 8) = o;
      }
    }
}

__device__ __forceinline__ void conv_phase(CParams& p, int gtid, int NT) {
    const bf16* proj = (const bf16*)(p.ws + WS_PROJ); bf16* xc = (bf16*)p.out;
    const float* cw = p.in[10]; const float* cb = p.in[11];
    constexpr int RUN = 32;
    for (int idx = gtid; idx < (TOK / RUN) * 256; idx += NT) {
        const int ch = (idx & 255) * 8, t0 = (idx >> 8) * RUN;
        float w[4][8], bs[8];
#pragma unroll
        for (int j = 0; j < 4; ++j) { const f32x4 a = *(const f32x4*)(cw + j * 2048 + ch), b = *(const f32x4*)(cw + j * 2048 + ch + 4); w[j][0] = a.x; w[j][1] = a.y; w[j][2] = a.z; w[j][3] = a.w; w[j][4] = b.x; w[j][5] = b.y; w[j][6] = b.z; w[j][7] = b.w; }
        { const f32x4 a = *(const f32x4*)(cb + ch), b = *(const f32x4*)(cb + ch + 4); bs[0] = a.x; bs[1] = a.y; bs[2] = a.z; bs[3] = a.w; bs[4] = b.x; bs[5] = b.y; bs[6] = b.z; bs[7] = b.w; }
        const bf16* src = proj + (size_t)t0 * ODD_IN + 2048 + ch; bf16* dst = xc + (size_t)t0 * 2048 + ch;
        v4u x0 = (v4u){0u, 0u, 0u, 0u}, x1 = x0, x2 = x0;
        if ((t0 & (SEQL - 1)) != 0) { x0 = *(const v4u*)(src - 3 * ODD_IN); x1 = *(const v4u*)(src - 2 * ODD_IN); x2 = *(const v4u*)(src - 1 * ODD_IN); }
        for (int sb = 0; sb < RUN; sb += 8) {
          v4u xin[8];
#pragma unroll
          for (int i = 0; i < 8; ++i) xin[i] = *(const v4u*)(src + (size_t)(sb + i) * ODD_IN);
#pragma unroll
          for (int i = 0; i < 8; ++i) { const int s = sb + i;
            const v4u x3 = xin[i];
            float acc[8];
#pragma unroll
            for (int k = 0; k < 8; ++k) {
                const unsigned a0 = (k < 2) ? x0.x : (k < 4) ? x0.y : (k < 6) ? x0.z : x0.w, a1 = (k < 2) ? x1.x : (k < 4) ? x1.y : (k < 6) ? x1.z : x1.w;
                const unsigned a2 = (k < 2) ? x2.x : (k < 4) ? x2.y : (k < 6) ? x2.z : x2.w, a3 = (k < 2) ? x3.x : (k < 4) ? x3.y : (k < 6) ? x3.z : x3.w;
                const float f0 = (k & 1) ? bfhi(a0) : bflo(a0), f1 = (k & 1) ? bfhi(a1) : bflo(a1), f2 = (k & 1) ? bfhi(a2) : bflo(a2), f3 = (k & 1) ? bfhi(a3) : bflo(a3);
                acc[k] = bs[k] + w[0][k] * f0 + w[1][k] * f1 + w[2][k] * f2 + w[3][k] * f3;
            }
            v4u o; o.x = pk2(acc[0], acc[1]); o.y = pk2(acc[2], acc[3]); o.z = pk2(acc[4], acc[5]); o.w = pk2(acc[6], acc[7]);
            *(v4u*)(dst + (size_t)s * 2048) = o;
            x0 = x1; x1 = x2; x2 = x3;
          }
        }
    }
}

constexpr int SCH = 128, SLEN = SEQL / SCH;
template <int PASS> __device__ __forceinline__ void scan_phase(CParams& p, LAS unsigned char* ldsb, int wave, int lane) {
    const bf16* gates = (const bf16*)(p.ws + WS_GATES); bf16* xc = (bf16*)p.out; const bf16* proj = (const bf16*)(p.ws + WS_PROJ);
    float* cA = (float*)(p.ws + WS_CARRY); float* cH = cA + 4 * SCH * 2048;
    float* sA = cH + 4 * SCH * 2048; float* sH = sA + 4 * (SCH / 8) * 2048;
    for (int wgi = blockIdx.x; wgi < 4 * (SCH / 8) * 4; wgi += gridDim.x) {
        const int grp = wgi & 3, sc = (wgi >> 2) & (SCH / 8 - 1), b = wgi / (4 * (SCH / 8)), c = sc * 8 + wave;
        const int ch = grp * 512 + lane * 8, n = ch >> 8, e = ch & 255;
        float sp8[8], b0[8], b1[8];
#pragma unroll
        for (int q = 0; q < 2; ++q) { const f32x4 lm = *(const f32x4*)(p.in[14] + ch + 4 * q), g0 = *(const f32x4*)(p.in[13] + ch + 4 * q), g1 = *(const f32x4*)(p.in[13] + 2048 + ch + 4 * q);
#pragma unroll
          for (int k = 0; k < 4; ++k) { sp8[4 * q + k] = -8.0f * LOG2E * log1pf(expf(-lm[k])); b0[4 * q + k] = g0[k]; b1[4 * q + k] = g1[k]; } }
        float h[8], ap[8];
#pragma unroll
        for (int k = 0; k < 8; ++k) { h[k] = 0.f; ap[k] = 1.f; }
        if (PASS == 2) {
#pragma unroll 8
            for (int j = 0; j < sc; ++j) { const float* pa = sA + (size_t)(b * (SCH / 8) + j) * 2048 + ch; const float* ph_ = sH + (size_t)(b * (SCH / 8) + j) * 2048 + ch;
                const f32x4 a0 = *(const f32x4*)pa, a1 = *(const f32x4*)(pa + 4), h0 = *(const f32x4*)ph_, h1 = *(const f32x4*)(ph_ + 4);
#pragma unroll
                for (int k = 0; k < 4; ++k) { h[k] = a0[k] * h[k] + h0[k]; h[4 + k] = a1[k] * h[4 + k] + h1[k]; } }
#pragma unroll 8
            for (int j = sc * 8; j < c; ++j) { const float* pa = cA + (size_t)(b * SCH + j) * 2048 + ch; const float* ph_ = cH + (size_t)(b * SCH + j) * 2048 + ch;
                const f32x4 a0 = *(const f32x4*)pa, a1 = *(const f32x4*)(pa + 4), h0 = *(const f32x4*)ph_, h1 = *(const f32x4*)(ph_ + 4);
#pragma unroll
                for (int k = 0; k < 4; ++k) { h[k] = a0[k] * h[k] + h0[k]; h[4 + k] = a1[k] * h[4 + k] + h1[k]; } }
        }
        const size_t t0 = (size_t)b * SEQL + (size_t)c * SLEN;
        const bf16* gp = gates + t0 * 4096 + n * 512 + e; bf16* xp = xc + t0 * 2048 + ch; const bf16* yp = proj + t0 * ODD_IN + ch;
#define SCAN_STEP(G0v, G1v, XVv) do { float gg0[8], gg1[8], xx[8]; UNPK8(gg0, G0v); UNPK8(gg1, G1v); UNPK8(xx, XVv); \
            _Pragma("unroll") for (int k = 0; k < 8; ++k) { \
                const float r = sigmoidf_(gg0[k] + b0[k]), ig = sigmoidf_(gg1[k] + b1[k]); \
                const float a = __builtin_amdgcn_exp2f(r * sp8[k]);                    \
                const float u = sqrtf(fmaxf(1.0f - a * a, 0.f)) * (ig * xx[k]); \
                h[k] = a * h[k] + u; ap[k] *= a; } } while (0)
        if (PASS == 1) {
            constexpr int BS = 4;
            v4u gA0[BS], gA1[BS], xA[BS], gB0[BS], gB1[BS], xB[BS];
#define SCAN_LOAD1(g0_, g1_, x_, s0_) do { _Pragma("unroll") for (int i = 0; i < BS; ++i) { const size_t s_ = (size_t)((s0_) + i); \
                g0_[i] = *(const v4u*)(gp + s_ * 4096); g1_[i] = *(const v4u*)(gp + s_ * 4096 + 256); x_[i] = *(const v4u*)(xp + s_ * 2048); } } while (0)
#define SCAN_RUN1(g0_, g1_, x_) do { _Pragma("unroll") for (int i = 0; i < BS; ++i) { SCAN_STEP(g0_[i], g1_[i], x_[i]); } } while (0)
            SCAN_LOAD1(gA0, gA1, xA, 0);
#pragma unroll 1
            for (int s0 = 0; s0 < SLEN; s0 += 2 * BS) {
                SCAN_LOAD1(gB0, gB1, xB, s0 + BS);
                SCAN_RUN1(gA0, gA1, xA);
                if (s0 + 2 * BS < SLEN) SCAN_LOAD1(gA0, gA1, xA, s0 + 2 * BS);
                SCAN_RUN1(gB0, gB1, xB);
            }
#undef SCAN_LOAD1
#undef SCAN_RUN1
        } else {
            constexpr int BS = 4;
            v4u gA0[BS], gA1[BS], xA[BS], yA[BS], gB0[BS], gB1[BS], xB[BS], yB[BS];
#define SCAN_LOAD(g0_, g1_, x_, y_, s0_) do { _Pragma("unroll") for (int i = 0; i < BS; ++i) { const size_t s_ = (size_t)((s0_) + i); \
                g0_[i] = *(const v4u*)(gp + s_ * 4096); g1_[i] = *(const v4u*)(gp + s_ * 4096 + 256); x_[i] = *(const v4u*)(xp + s_ * 2048); y_[i] = *(const v4u*)(yp + s_ * ODD_IN); } } while (0)
#define SCAN_RUN(g0_, g1_, x_, y_, s0_) do { _Pragma("unroll") for (int i = 0; i < BS; ++i) { SCAN_STEP(g0_[i], g1_[i], x_[i]); \
                float yy[8]; UNPK8(yy, y_[i]); v4u ov; ov.x = pk2(h[0] * yy[0], h[1] * yy[1]); ov.y = pk2(h[2] * yy[2], h[3] * yy[3]); ov.z = pk2(h[4] * yy[4], h[5] * yy[5]); ov.w = pk2(h[6] * yy[6], h[7] * yy[7]); \
                *(v4u*)(xp + (size_t)((s0_) + i) * 2048) = ov; } } while (0)
            SCAN_LOAD(gA0, gA1, xA, yA, 0);
#pragma unroll
            for (int s0 = 0; s0 < SLEN; s0 += 2 * BS) {
                SCAN_LOAD(gB0, gB1, xB, yB, s0 + BS);
                SCAN_RUN(gA0, gA1, xA, yA, s0);
                if (s0 + 2 * BS < SLEN) SCAN_LOAD(gA0, gA1, xA, yA, s0 + 2 * BS);
                SCAN_RUN(gB0, gB1, xB, yB, s0 + BS);
            }
#undef SCAN_LOAD
#undef SCAN_RUN
        }
#undef SCAN_STEP
        if (PASS == 1) { float* pa = cA + (size_t)(b * SCH + c) * 2048 + ch; float* ph_ = cH + (size_t)(b * SCH + c) * 2048 + ch;
            *(f32x4*)pa = (f32x4){ap[0], ap[1], ap[2], ap[3]}; *(f32x4*)(pa + 4) = (f32x4){ap[4], ap[5], ap[6], ap[7]};
            *(f32x4*)ph_ = (f32x4){h[0], h[1], h[2], h[3]}; *(f32x4*)(ph_ + 4) = (f32x4){h[4], h[5], h[6], h[7]}; }
        if (PASS == 1) {
            LAS float* L = (LAS float*)ldsb + (wave * 512 + lane * 8) * 2;
#pragma unroll
            for (int k = 0; k < 8; ++k) { L[2 * k] = ap[k]; L[2 * k + 1] = h[k]; }
            __syncthreads();
            if (wave == 0) { float ca[8], chh[8];
#pragma unroll
                for (int k = 0; k < 8; ++k) { ca[k] = 1.f; chh[k] = 0.f; }
                for (int w = 0; w < 8; ++w) { const LAS float* Lw = (const LAS float*)ldsb + (w * 512 + lane * 8) * 2;
#pragma unroll
                    for (int k = 0; k < 8; ++k) { const float a = Lw[2 * k], hh = Lw[2 * k + 1]; chh[k] = a * chh[k] + hh; ca[k] *= a; } }
                float* pa = sA + (size_t)(b * (SCH / 8) + sc) * 2048 + ch; float* ph_ = sH + (size_t)(b * (SCH / 8) + sc) * 2048 + ch;
                *(f32x4*)pa = (f32x4){ca[0], ca[1], ca[2], ca[3]}; *(f32x4*)(pa + 4) = (f32x4){ca[4], ca[5], ca[6], ca[7]};
                *(f32x4*)ph_ = (f32x4){chh[0], chh[1], chh[2], chh[3]}; *(f32x4*)(ph_ + 4) = (f32x4){chh[4], chh[5], chh[6], chh[7]}; }
            __syncthreads();
        }
    }
}

__device__ __forceinline__ void attention_phase(CParams& p, char* lds, const int tid) {
    using abf = attn_body::bf16;
    const abf* proj = (const abf*)(p.ws + WS_PROJ); abf* att = (abf*)(p.ws + WS_ATT); abf* mixin = (abf*)(p.ws + WS_MIXIN);
    const int G = gridDim.x, c = blockIdx.x, nd = (2048 + G - 1) / G, ns = (1024 + G - 1) / G;
    for (int i = 0; i < nd + ns; ++i) {
        const abf *Qp, *Kp, *Vp; abf* Op; int q0, t0; bool swa; float sink_l2 = 0.f;
        if (i < nd) {
            const int pos = (i & 1) ? G - 1 - c : c, L = i * G + pos;
            if (L >= 2048) continue;
            int qb = 15 - (L >> 7), combo = L & 127, b = combo >> 5, ic = combo & 31, hq = ic >> 1, cc = ic & 1;
            if (G == 256) {
                const int xcd = pos & 7, slot = pos >> 3, member = slot & 3, cl = (slot >> 2) & 3, half = slot >> 4, cluster = xcd * 4 + cl;
                b = cluster >> 3; hq = 2 * (cluster & 7) + (member >> 1); cc = member & 1; ic = 2 * hq + cc; qb = 15 - (2 * i + half);
            }
            const abf* base = proj + (size_t)b * SEQL * EVEN_IN;
            Qp = base + hq * 64; Kp = base + 1024 + hq * 64; Vp = base + 2048 + (hq >> 1) * 128 + cc * 64; Op = att + (size_t)b * SEQL * 2048 + ic * 64; q0 = qb * 256; t0 = 0; swa = false;
        } else {
            const int L = (i - nd) * G + c; if (L >= 1024) continue;
            const int b = L >> 8, hq = (L >> 4) & 15, qb = L & 15;
            const abf* base = proj + (size_t)b * SEQL * EVEN_IN;
            sink_l2 = p.in[7][hq] * LOG2E;
            Qp = base + 3072 + hq * 64; Kp = base + 4096 + (hq >> 3) * 64; Vp = base + 4224 + (hq >> 3) * 64; Op = mixin + (size_t)b * SEQL * 2048 + 1024 + hq * 64; q0 = qb * 256; t0 = qb ? qb * 4 - 2 : 0; swa = true;
        }
        attn_body::attn_unit<8>(Qp, Kp, Vp, Op, q0, t0, swa, sink_l2, lds, tid);
    }
}

#define RLX_AGENT __ATOMIC_RELAXED, __HIP_MEMORY_SCOPE_AGENT
constexpr int CW_BAR = 4096;
constexpr size_t CTL_ZERO_BYTES = 65536;
#define XB_TMO      128
#define XB_XCNT(j)  (256  + 64 * (j))
#define XB_XSUB(j)  (1280 + 64 * (j))
#define XB_XGEN(j)  (2304 + 64 * (j))
#define XB_TOP      3328
#define XB_TOPGEN   3392
#define XCD_BAR_WORDS 3456
#define XB_SPIN_CAP (1u << 18)

__device__ __forceinline__ unsigned xb_ld(unsigned* p)              { return __hip_atomic_load(p, __ATOMIC_RELAXED, __HIP_MEMORY_SCOPE_AGENT); }
__device__ __forceinline__ unsigned xb_add(unsigned* p, unsigned v) { return __hip_atomic_fetch_add(p, v, __ATOMIC_RELAXED, __HIP_MEMORY_SCOPE_AGENT); }
__device__ __forceinline__ unsigned xb_xcc_id() { return (unsigned)__builtin_amdgcn_s_getreg((3 << 11) | 20) & 0xFu; }
#define XB_SPIN(cond, bar) do { unsigned _sp = 0; while (cond) { __builtin_amdgcn_s_sleep(1); \
    if ((++_sp & 255u) == 0u) { if (xb_ld(&(bar)[XB_TMO])) break; if (_sp > XB_SPIN_CAP) { atomicAdd(&(bar)[XB_TMO], 1u); break; } } } } while (0)

struct XcdBarrier {
    unsigned* bar; unsigned x;
    volatile LAS unsigned* st;
};

__device__ __forceinline__ XcdBarrier xcd_barrier_post(unsigned* bar, volatile LAS unsigned* st) {
    XcdBarrier b; b.bar = bar; b.x = xb_xcc_id(); b.st = st;
    if (threadIdx.x == 0) (void)xb_add(&bar[XB_XCNT(b.x)], 1u);
    return b;
}
__device__ __forceinline__ void xcd_barrier_complete(unsigned* bar, unsigned x, unsigned& nloc, unsigned& nx) {
    const unsigned G = gridDim.x * gridDim.y * gridDim.z;
    unsigned sum, cnt, mine, sp = 0u;
    for (;;) {
        sum = 0u; cnt = 0u; mine = 0u;
#pragma unroll
        for (unsigned j = 0; j < 16; ++j) { const unsigned c = xb_ld(&bar[XB_XCNT(j)]); sum += c; cnt += (c > 0u) ? 1u : 0u; mine = (j == x) ? c : mine; }
        if (sum == G) break;
        __builtin_amdgcn_s_sleep(1);
        if ((++sp & 255u) == 0u) { if (xb_ld(&bar[XB_TMO])) break; if (sp > XB_SPIN_CAP) { atomicAdd(&bar[XB_TMO], 1u); break; } }
    }
    nloc = mine > 0u ? mine : 1u; nx = cnt > 0u ? cnt : 1u;
}

__device__ __forceinline__ void xcd_barrier(const XcdBarrier& b, const bool leader_thread) {
    asm volatile("s_waitcnt vmcnt(0)" ::: "memory");
    __syncthreads();
    if (leader_thread) {
        unsigned* bar = b.bar;
        __builtin_amdgcn_s_waitcnt(0);
        unsigned nloc = b.st[0], nx = b.st[1];
        if (nloc == 0u) { xcd_barrier_complete(bar, b.x, nloc, nx); b.st[0] = nloc; b.st[1] = nx; }
        const unsigned old = xb_add(&bar[XB_XSUB(b.x)], 1u);
        const unsigned gen = old / nloc;
        if (old + 1u == (gen + 1u) * nloc) {
            __builtin_amdgcn_fence(__ATOMIC_RELEASE, "agent");
            asm volatile("s_waitcnt vmcnt(0)" ::: "memory");
            const unsigned og = xb_add(&bar[XB_TOP], 1u);
            const unsigned tg = og / nx;
            if (og + 1u == (tg + 1u) * nx) xb_add(&bar[XB_TOPGEN], 1u);
            else XB_SPIN(xb_ld(&bar[XB_TOPGEN]) == tg, bar);
            __builtin_amdgcn_fence(__ATOMIC_ACQUIRE, "agent");
            xb_add(&bar[XB_XGEN(b.x)], 1u);
            asm volatile("s_waitcnt vmcnt(0)" ::: "memory");
        } else {
            XB_SPIN(xb_ld(&bar[XB_XGEN(b.x)]) == gen, bar);
            __builtin_amdgcn_fence(__ATOMIC_ACQUIRE, "agent");
            asm volatile("s_waitcnt vmcnt(0)" ::: "memory");
        }
    }
    __syncthreads();
}

#ifndef MK_PER_PHASE
#define MK_PER_PHASE 0
#endif
__global__ void __launch_bounds__(NWAVES * 64, 2) mega_fwd(Params p_unused) {
    extern __shared__ __attribute__((aligned(16))) unsigned char lds[];
    cg::grid_group grid = cg::this_grid();
    const int G = gridDim.x, NGW = G * NWAVES;
    int lo, hi; { CParams& p = *kargs(); lo = p.lo; hi = p.hi; }
    for (int u = threadIdx.x; u < (LDS_BYTES - LDSCTL_OFF) / 4; u += NWAVES * 64) ((LAS unsigned*)((LAS unsigned char*)lds + LDSCTL_OFF))[u] = 0u;
#if defined(PROBE_POLL)
    if (threadIdx.x == 0) ((volatile LAS unsigned*)((LAS unsigned char*)lds + 131072 + 6144))[0] = 0u;
#endif
    __syncthreads();
    ((volatile LAS unsigned*)((LAS unsigned char*)lds + MISC_OFF + 128))[(int)(__builtin_amdgcn_s_getreg((31 << 11) | 4) & 63u)] = threadIdx.x >> 6;
    __syncthreads();
    (void)xcd_barrier_post((unsigned*)kargs()->ws + CW_BAR, (volatile LAS unsigned*)((LAS unsigned char*)lds + MISC_OFF) + 8);
#define IN(k) (lo <= (k) && (k) < hi)
#define IS_T0() (lane_id_v() == 0 && ((volatile LAS unsigned*)((LAS unsigned char*)lds + MISC_OFF + 128))[(int)(__builtin_amdgcn_s_getreg((31 << 11) | 4) & 63u)] == 0u)
#ifdef PROBE_MASK
#define PRW ((volatile LAS unsigned*)((LAS unsigned char*)lds + MISC_OFF))
    if (threadIdx.x == 0) { PRW[0] = (unsigned)__builtin_amdgcn_s_memrealtime(); PRW[1] = 0u; }
#define PROBE_STAMP(k) do { if (IS_T0()) { const unsigned now_ = (unsigned)__builtin_amdgcn_s_memrealtime(); if (((PROBE_MASK) >> (k)) & 1) PRW[1] += now_ - PRW[0]; PRW[0] = now_; } } while (0)
#else
#define PROBE_STAMP(k) do { } while (0)
#endif
#define SEAM(k) do { if (IN(k) && IN((k) + 1)) { if ((k) == 0 && hi > 1000) grid.sync(); else { XcdBarrier bar; bar.bar = (unsigned*)kargs()->ws + CW_BAR; bar.x = xb_xcc_id(); bar.st = (volatile LAS unsigned*)((LAS unsigned char*)lds + MISC_OFF) + 8; xcd_barrier(bar, IS_T0()); } } PROBE_STAMP(k); } while (0)
#define HWSLOT() ((int)(__builtin_amdgcn_s_getreg((31 << 11) | 4) & 63u))
#define ROOTS() int lane; asm volatile("v_mbcnt_lo_u32_b32 %0, -1, 0\n\tv_mbcnt_hi_u32_b32 %0, -1, %0" : "=v"(lane)); \
    const int wave = __builtin_amdgcn_readfirstlane((int)((volatile LAS unsigned*)((LAS unsigned char*)lds + MISC_OFF + 128))[HWSLOT()]); \
    int tid = wave * 64 + lane; asm volatile("" : "+v"(tid)); const int gw = blockIdx.x * NWAVES + wave; (void)gw; \
    CParams& p = *kargs(); unsigned char* ws = p.ws; bf16* H = (bf16*)(ws + WS_H); bf16* MIX = (bf16*)(ws + WS_MIX); float* RS = (float*)(ws + WS_RS); (void)H; (void)MIX; (void)RS
#define GEMM_PHASE(k, Aptr, LDA, Bptr, LDB, NN, KK, AGRP, Optr, LDC, MODE, RSP) do { if (IN(k)) { ROOTS(); \
        pg8::Gemm g; g.A = (Aptr); g.Bt = (Bptr); g.M = TOK; g.N = (NN); g.K = (KK); g.lda = (LDA); g.ldb = (LDB); g.agrp = (AGRP); \
        pg8::EpiAct E; E.O = (Optr); E.ldc = (LDC); E.mode = (MODE); E.rs = (RSP); \
        pg8::StaticOrder S; S.init(TOK, (NN), G, (int)blockIdx.x); \
        pg8::gemm_phase<pg8::EpiAct, pg8::StaticOrder, true, true>((PG8_LAS unsigned char*)lds, g, S, E, tid); } SEAM(k); } while (0)

#define GEMM_FUSED(k, Aptr, LDA, Bptr, LDB, KK, GPOST, SSQ, OUTF, BANK) do { if (IN(k)) { ROOTS(); \
        pg8::Gemm g; g.A = (Aptr); g.Bt = (Bptr); g.M = TOK; g.N = DMODEL; g.K = (KK); g.lda = (LDA); g.ldb = (LDB); g.agrp = 0; \
        pg8::EpiResNorm E; E.XB = H; E.gpost = (GPOST); E.ssq_out = (SSQ); E.out_f32 = (OUTF); E.xbuf = (float*)(ws + WS_XBUF) + (size_t)(BANK) * TOK * 8; E.cnt = (unsigned*)ws + CW_X + (BANK) * 1024; \
        E.ldsx = (PG8_LAS unsigned char*)lds + 131072; \
        pg8::StaticOrder S; S.init(TOK, DMODEL, G, (int)blockIdx.x); S.wgm = 4; \
        pg8::gemm_phase<pg8::EpiResNorm, pg8::StaticOrder, true, true>((PG8_LAS unsigned char*)lds, g, S, E, tid); } SEAM(k); } while (0)
    if (IN(0)) { ROOTS(); LAS float* scr = (LAS float*)((LAS unsigned char*)lds + wave * TR_WAVE_BYTES);
        for (int z = gw * 64 + lane; z < 3 * TOK; z += NGW * 64) RS[TOK + z] = 0.f;
        convert_weights(p, 0, 1, scr, gw, NGW, lane); row_phase(p.in[0], nullptr, nullptr, nullptr, H, RS, nullptr, gw, NGW, lane); }
    SEAM(0);
    if (IN(1)) { { ROOTS();
        pg8::Gemm g; g.A = H; g.Bt = (bf16*)(ws + WS_WIN); g.M = TOK; g.N = EVEN_IN; g.K = DMODEL; g.lda = DMODEL; g.ldb = DMODEL; g.agrp = 0;
        pg8::EpiAct E; E.O = (bf16*)(ws + WS_PROJ); E.ldc = EVEN_IN; E.mode = 3; E.rs = RS;
        pg8::StaticOrder S; S.init(TOK, EVEN_IN, G, (int)blockIdx.x);
        pg8::gemm_phase<pg8::EpiAct, pg8::StaticOrder, true, true>((PG8_LAS unsigned char*)lds, g, S, E, tid); }
        ROOTS(); (void)tid;
        const int rem = ((TOK / 256) * (EVEN_IN / 256)) % G, c = (int)blockIdx.x;
        LAS float* scr = (LAS float*)((LAS unsigned char*)lds + wave * TR_WAVE_BYTES);
        if (rem == 0) convert_weights(p, 0, 2, scr, gw, NGW, lane);
        else if (c >= rem) convert_weights(p, 0, 2, scr, (c - rem) * NWAVES + wave, (G - rem) * NWAVES, lane);
    }
    SEAM(1);
#ifndef NO_ATT
    if (IN(2)) { ROOTS(); attention_phase(p, (char*)lds, tid); }
#endif
    SEAM(2);
    if (IN(3)) { ROOTS(); diff_combine(p, gw, NGW, lane); }
    SEAM(3);
    GEMM_FUSED(4, (bf16*)(ws + WS_MIXIN), DMODEL, (bf16*)(ws + WS_WOUT), DMODEL, DMODEL, p.in[17], RS + TOK, nullptr, 0);
    GEMM_PHASE(6, H, DMODEL, (bf16*)(ws + WS_W1), DMODEL, DFF, DMODEL, 0, (bf16*)(ws + WS_Z), DFF, 1, RS + TOK);
    GEMM_FUSED(7, (bf16*)(ws + WS_Z), DFF, (bf16*)(ws + WS_W2), DFF, DFF, p.in[19], RS + 2 * TOK, nullptr, 1);
    if (IN(8)) { ROOTS(); LAS float* scr = (LAS float*)((LAS unsigned char*)lds + wave * TR_WAVE_BYTES);
        convert_weights(p, 1, 3, scr, gw, NGW, lane); }
    SEAM(8);
    GEMM_PHASE(9, H, DMODEL, (bf16*)(ws + WS_WIN), DMODEL, ODD_IN, DMODEL, 0, (bf16*)(ws + WS_PROJ), ODD_IN, 2, RS + 2 * TOK);
    if (IN(10)) { ROOTS(); conv_phase(p, blockIdx.x * (NWAVES * 64) + tid, G * NWAVES * 64); }
    SEAM(10);
    GEMM_PHASE(11, (bf16*)p.out, DMODEL, (bf16*)(ws + WS_WG), 256, 4096, 256, 1, (bf16*)(ws + WS_GATES), 4096, 0, nullptr);
#ifndef NO_SCAN
    if (IN(12)) { ROOTS(); scan_phase<1>(p, (LAS unsigned char*)lds, wave, lane); }
    SEAM(12);
    if (IN(13)) { ROOTS(); scan_phase<2>(p, (LAS unsigned char*)lds, wave, lane); }
    SEAM(13);
#endif
    GEMM_FUSED(14, (bf16*)p.out, DMODEL, (bf16*)(ws + WS_WOUT), DMODEL, DMODEL, p.in[17] + DMODEL, RS + 3 * TOK, nullptr, 2);
    GEMM_PHASE(16, H, DMODEL, (bf16*)(ws + WS_W1), DMODEL, DFF, DMODEL, 0, (bf16*)(ws + WS_Z), DFF, 1, RS + 3 * TOK);
    GEMM_FUSED(17, (bf16*)(ws + WS_Z), DFF, (bf16*)(ws + WS_W2), DFF, DFF, p.in[19] + DMODEL, nullptr, p.out, 3);
#if defined(PROBE_POLL)
    if (blockIdx.x == PROBE_POLL && IS_T0()) { asm volatile("s_waitcnt vmcnt(0)" ::: "memory"); kargs()->out[0] += 4.0f * rintf((float)((volatile LAS unsigned*)((LAS unsigned char*)lds + 131072 + 6144))[0] * 0.01f / 4.0f); }
#endif
#ifdef PROBE_MASK
    PROBE_STAMP(18);
    if (blockIdx.x == 0 && IS_T0()) { asm volatile("s_waitcnt vmcnt(0)" ::: "memory"); kargs()->out[0] += (float)(PROBE_Q) * rintf((float)PRW[1] * 0.01f / (float)(PROBE_Q)); }
#endif
#undef IN
#undef SEAM
#undef ROOTS
#undef GEMM_PHASE
#undef GEMM_FUSED
}

extern "C" void kernel_launch(void* const* d_in, const int* in_sizes, int n_in, void* d_out, int out_size, void* d_ws, size_t ws_size, hipStream_t stream) {
    static int grid = 0;
    if (grid == 0) {
        if (n_in != 22 || in_sizes[0] != TOK * DMODEL || out_size != TOK * DMODEL || ws_size < WS_END) { fprintf(stderr, "kernel_launch: unexpected shapes / workspace (n_in %d, in0 %d, out %d, ws %zu)\n", n_in, n_in > 0 ? in_sizes[0] : -1, out_size, ws_size); grid = -1; return; }
        int dev = 0, cus = 0, per_cu = 0;
        if (hipGetDevice(&dev) != hipSuccess || hipDeviceGetAttribute(&cus, hipDeviceAttributeMultiprocessorCount, dev) != hipSuccess) { grid = -1; return; }
        if (hipFuncSetAttribute((const void*)mega_fwd, hipFuncAttributeMaxDynamicSharedMemorySize, LDS_BYTES) != hipSuccess) { fprintf(stderr, "kernel_launch: hipFuncSetAttribute failed\n"); grid = -1; return; }
        if (hipOccupancyMaxActiveBlocksPerMultiprocessor(&per_cu, (const void*)mega_fwd, NWAVES * 64, LDS_BYTES) != hipSuccess || per_cu < 1) { per_cu = 1; (void)hipGetLastError(); }
        grid = cus * per_cu;
        if (grid != 256) { fprintf(stderr, "kernel_launch: the fused residual epilogues need exactly 256 co-resident workgroups (got %d)\n", grid); grid = -1; return; }
    }
    if (grid < 0) return;
    if (hipMemsetAsync(d_ws, 0, CTL_ZERO_BYTES, stream) != hipSuccess) { fprintf(stderr, "kernel_launch: hipMemsetAsync failed\n"); return; }
    Params p{};
    for (int i = 0; i < 22; ++i) p.in[i] = (const float*)d_in[i];
    p.out = (float*)d_out; p.ws = (unsigned char*)d_ws;
#if MK_PER_PHASE
    for (int ph = 0; ph < N_PHASES; ++ph) {
        p.lo = ph; p.hi = ph + 1; void* args[] = {&p};
        hipError_t e = hipLaunchCooperativeKernel((const void*)mega_fwd, dim3(grid), dim3(NWAVES * 64), args, LDS_BYTES, stream);
        if (e != hipSuccess) { fprintf(stderr, "cooperative launch failed: %s (grid %d)\n", hipGetErrorString(e), grid); break; }
    }
#else
    p.lo = 0; p.hi = N_PHASES; void* args[] = {&p};
    hipError_t e = hipLaunchCooperativeKernel((const void*)mega_fwd, dim3(grid), dim3(NWAVES * 64), args, LDS_BYTES, stream);
    if (e != hipSuccess) fprintf(stderr, "cooperative launch failed: %s (grid %d)\n", hipGetErrorString(e), grid);
#endif
}
```
